# Optimizing an MI355X kernel written in HIP

```python
import math
import jax
import jax.numpy as jnp
from jax import lax
import numpy as np

D_MODEL = 1024
BATCH = 8
SEQ = 4096
DEPTH = 2

N_META = 16
CHUNK = 128
PAD = CHUNK - N_META
HEAD_DIM = 64
SB_HEADS = 4
SB_W = SB_HEADS * HEAD_DIM
SSD_HEADS = 8
SSD_W = SSD_HEADS * HEAD_DIM
SSD_GROUPS = 2
SSD_STATE = 128
SSD_CONV = 4
SSD_CONV_DIM = SSD_W + 2 * SSD_GROUPS * SSD_STATE
HG_HEADS = 4
HG_DK = 64
HG_DV = 64
HG_W = HG_HEADS * HG_DV
D_MIX = SB_W + SSD_W + HG_W
D_FF = 4 * D_MODEL
EPS = 1e-6
TINY = 1e-30
IN_SIZES = (SB_W, SB_W, SB_W,
            SSD_W, SSD_W, SSD_GROUPS * SSD_STATE, SSD_GROUPS * SSD_STATE, SSD_HEADS,
            HG_HEADS * HG_DK, HG_HEADS * HG_DK, HG_W, HG_W)
D_IN = 3 * SB_W + 2 * SSD_W + 2 * SSD_GROUPS * SSD_STATE + SSD_HEADS + 2 * HG_HEADS * HG_DK + 2 * HG_W

kernel_name = 'hymba_sb_ssd_hgrn2_block'


def rmsnorm(x, w):
    xf = x.astype(jnp.float32)
    y = xf * lax.rsqrt(jnp.mean(xf * xf, axis=-1, keepdims=True) + EPS)
    return (y * w.astype(jnp.float32)).astype(x.dtype)


def causal_depthwise_conv(u, w, b):
    y = lax.conv_general_dilated(
        u, w[:, None, :].astype(u.dtype), window_strides=(1,), padding=[(w.shape[0] - 1, 0)],
        dimension_numbers=('NWC', 'WIO', 'NWC'), feature_group_count=u.shape[-1])
    return y + b.astype(u.dtype)


def to_chunks(t):
    b, l = t.shape[:2]
    return jnp.moveaxis(t.reshape((b, l // CHUNK, CHUNK) + t.shape[2:]), 1, 0)


def from_chunks(t):
    n, b = t.shape[:2]
    return jnp.moveaxis(t, 0, 1).reshape((b, n * CHUNK) + t.shape[3:])


def masked_decay(seg, mask):
    return jnp.where(mask, jnp.exp(jnp.where(mask, seg, 0.0)), 0.0)


def stick_breaking_attention(q, k, v, valid):
    L, dh = q.shape[2], q.shape[3]
    scale = dh ** -0.5
    pos = jnp.arange(L)
    outs = []
    for blk in range(L // CHUNK):
        start, end = blk * CHUNK, (blk + 1) * CHUNK
        z = jnp.einsum('bhqd,bhkd->bhqk', q[:, :, start:end], k[:, :, :end]).astype(jnp.float32) * scale
        mask = (pos[None, :end] < pos[start:end, None]) & valid[None, :end]
        log_keep = jnp.where(mask, jax.nn.log_sigmoid(-z), 0.0)
        csum = jnp.cumsum(log_keep, axis=-1)
        log_w = jax.nn.log_sigmoid(z) + (csum[..., -1:] - csum)
        w = jnp.where(mask, jnp.exp(jnp.where(mask, log_w, 0.0)), 0.0)
        outs.append(jnp.einsum('bhqk,bhkd->bhqd', w.astype(v.dtype), v[:, :, :end]))
    return jnp.concatenate(outs, axis=2)


def stick_breaking_group(q, k, v, q_norm, k_norm, out_norm, valid):
    bsz, L, _ = q.shape
    shp = (bsz, L, SB_HEADS, HEAD_DIM)
    qh = jnp.transpose(rmsnorm(q.reshape(shp), q_norm), (0, 2, 1, 3))
    kh = jnp.transpose(rmsnorm(k.reshape(shp), k_norm), (0, 2, 1, 3))
    vh = jnp.transpose(v.reshape(shp), (0, 2, 1, 3))
    o = jnp.transpose(stick_breaking_attention(qh, kh, vh, valid), (0, 2, 1, 3))
    return rmsnorm(o, out_norm).reshape(bsz, L, SB_W)


def ssd_chunked(xdt, a, bm, cm):
    bsz = xdt.shape[0]
    rep = SSD_HEADS // SSD_GROUPS
    causal = jnp.tril(jnp.ones((CHUNK, CHUNK), dtype=bool))

    def step(state, inp):
        a_c, x_c, b_c, c_c = inp
        acum = jnp.cumsum(a_c, axis=1)
        seg = acum[:, :, None, :] - acum[:, None, :, :]
        decay = masked_decay(seg, causal[None, :, :, None])
        cb = jnp.repeat(jnp.einsum('btgn,bsgn->btsg', c_c, b_c), rep, axis=-1)
        y_diag = jnp.einsum('btsh,bshp->bthp', cb * decay, x_c)
        c_h = jnp.repeat(c_c, rep, axis=2)
        b_h = jnp.repeat(b_c, rep, axis=2)
        y_off = jnp.einsum('bthn,bhpn->bthp', c_h, state) * jnp.exp(acum)[..., None]
        w_end = jnp.exp(acum[:, -1:, :] - acum)
        state = state * jnp.exp(acum[:, -1, :])[:, :, None, None] + jnp.einsum('bshn,bsh,bshp->bhpn', b_h, w_end, x_c)
        return state, y_diag + y_off

    state0 = jnp.zeros((bsz, SSD_HEADS, HEAD_DIM, SSD_STATE), jnp.float32)
    xs = tuple(to_chunks(t.astype(jnp.float32)) for t in (a, xdt, bm, cm))
    _, y = lax.scan(step, state0, xs)
    return from_chunks(y)


def ssd_group(z, xs, bm, cm, dt_raw, conv_w, conv_b, dt_bias, a_log, d_skip, norm_w, vmask):
    bsz, L, _ = xs.shape
    f32 = jnp.float32
    xbc = jax.nn.silu(causal_depthwise_conv(jnp.concatenate([xs, bm, cm], axis=-1) * vmask, conv_w, conv_b))
    xs, bm, cm = jnp.split(xbc, [SSD_W, SSD_W + SSD_GROUPS * SSD_STATE], axis=-1)
    dt = jax.nn.softplus(dt_raw.astype(f32) + dt_bias.astype(f32)) * vmask.astype(f32)
    a_neg = -jnp.exp(a_log.astype(f32))
    xh = xs.reshape(bsz, L, SSD_HEADS, HEAD_DIM).astype(f32)
    y = ssd_chunked(xh * dt[..., None], dt * a_neg,
                    bm.reshape(bsz, L, SSD_GROUPS, SSD_STATE), cm.reshape(bsz, L, SSD_GROUPS, SSD_STATE))
    y = y + xh * d_skip.astype(f32)[:, None]
    y = y.reshape(bsz, L, SSD_W) * jax.nn.silu(z.astype(f32))
    y = rmsnorm(y.reshape(bsz, L, SSD_GROUPS, SSD_W // SSD_GROUPS), norm_w)
    return y.reshape(bsz, L, SSD_W).astype(z.dtype)


def hgrn2_chunked(q, k, v, log_f):
    bsz = q.shape[0]
    causal = jnp.tril(jnp.ones((CHUNK, CHUNK), dtype=bool))

    def step(S, inp):
        q_c, k_c, v_c, g_c = inp
        gcum = jnp.cumsum(g_c, axis=1)
        seg = gcum[:, :, None] - gcum[:, None, :]
        decay = masked_decay(seg, causal[None, :, :, None, None])
        scores = jnp.einsum('bthk,btshk,bshk->btsh', q_c, decay, k_c)
        o_intra = jnp.einsum('btsh,bshv->bthv', scores, v_c)
        o_inter = jnp.einsum('bthk,bhkv->bthv', q_c * jnp.exp(gcum), S)
        k_end = k_c * jnp.exp(gcum[:, -1:] - gcum)
        S = S * jnp.exp(gcum[:, -1])[..., None] + jnp.einsum('bshk,bshv->bhkv', k_end, v_c)
        return S, o_intra + o_inter

    S0 = jnp.zeros((bsz, HG_HEADS, HG_DK, HG_DV), jnp.float32)
    _, o = lax.scan(step, S0, tuple(to_chunks(t) for t in (q, k, v, log_f)))
    return from_chunks(o)


def hgrn2_group(q, f_logit, i_in, g, lb, out_norm, valid):
    bsz, L, _ = q.shape
    f32 = jnp.float32
    fl = f_logit.astype(f32)
    keep = valid[None, :, None]
    f = lb + (1.0 - lb) * jax.nn.sigmoid(fl)
    log_f = jnp.where(keep, jnp.log(jnp.maximum(f, TINY)), 0.0)
    k = jnp.where(keep, (1.0 - lb) * jax.nn.sigmoid(-fl), 0.0)
    v = jnp.where(keep, i_in.astype(f32), 0.0)
    qf = jax.nn.silu(q.astype(f32))
    shp = (bsz, L, HG_HEADS, HG_DK)
    o = hgrn2_chunked(qf.reshape(shp), k.reshape(shp), v.reshape(bsz, L, HG_HEADS, HG_DV), log_f.reshape(shp))
    o = rmsnorm(o, out_norm) * jax.nn.silu(g.astype(f32)).reshape(bsz, L, HG_HEADS, HG_DV)
    return o.reshape(bsz, L, HG_W).astype(q.dtype)


def setup_inputs(seed: int = 0) -> dict:
    key = jax.random.key(seed)
    ks = jax.random.split(key, 19)
    f32 = jnp.float32

    def normal(k, shape, scale):
        return scale * jax.random.normal(k, shape, f32)

    def gain(k, shape):
        return 1.0 + 0.01 * jax.random.normal(k, shape, f32)

    dt_init = jnp.exp(jax.random.uniform(ks[10], (DEPTH, SSD_HEADS), f32,
                                         minval=math.log(1e-3), maxval=math.log(1e-1)))
    return {
        'x': normal(ks[0], (BATCH, SEQ, D_MODEL), 1.0),
        'meta_tokens': normal(ks[1], (N_META, D_MODEL), 1.0),
        'hg_lb_logits': normal(ks[2], (DEPTH, HG_HEADS * HG_DK), 0.5),
        'norm_mix_w': gain(ks[3], (DEPTH, D_MODEL)),
        'w_in': normal(ks[4], (DEPTH, D_MODEL, D_IN), D_MODEL ** -0.5),
        'sb_q_norm': gain(ks[5], (DEPTH, HEAD_DIM)),
        'sb_k_norm': gain(ks[6], (DEPTH, HEAD_DIM)),
        'sb_out_norm': gain(ks[7], (DEPTH, SB_HEADS, HEAD_DIM)),
        'ssd_conv_w': normal(ks[8], (DEPTH, SSD_CONV, SSD_CONV_DIM), SSD_CONV ** -0.5),
        'ssd_conv_b': normal(ks[9], (DEPTH, SSD_CONV_DIM), 0.01),
        'ssd_dt_bias': dt_init + jnp.log(-jnp.expm1(-dt_init)),
        'ssd_A_log': jnp.log(jax.random.uniform(ks[11], (DEPTH, SSD_HEADS), f32, minval=1.0, maxval=16.0)),
        'ssd_D': gain(ks[12], (DEPTH, SSD_HEADS)),
        'ssd_norm_w': gain(ks[13], (DEPTH, SSD_GROUPS, SSD_W // SSD_GROUPS)),
        'hg_out_norm': gain(ks[14], (DEPTH, HG_HEADS, HG_DV)),
        'w_out': normal(ks[15], (DEPTH, D_MIX, D_MODEL), D_MIX ** -0.5),
        'norm_mlp_w': gain(ks[16], (DEPTH, D_MODEL)),
        'w_up': normal(ks[17], (DEPTH, D_MODEL, D_FF), D_MODEL ** -0.5),
        'w_down': normal(ks[18], (DEPTH, D_FF, D_MODEL), D_FF ** -0.5),
    }


def reference(x, meta_tokens, hg_lb_logits, norm_mix_w, w_in, sb_q_norm, sb_k_norm, sb_out_norm,
              ssd_conv_w, ssd_conv_b, ssd_dt_bias, ssd_A_log, ssd_D, ssd_norm_w, hg_out_norm,
              w_out, norm_mlp_w, w_up, w_down):
    bsz = x.shape[0]
    dtype = x.dtype
    lead = jnp.concatenate([jnp.zeros((PAD, D_MODEL), dtype), meta_tokens.astype(dtype)], axis=0)
    h = jnp.concatenate([jnp.broadcast_to(lead[None], (bsz, CHUNK, D_MODEL)), x], axis=1)
    L = h.shape[1]
    valid = jnp.arange(L) >= PAD
    vmask = valid[None, :, None].astype(dtype)
    probs = jax.nn.softmax(hg_lb_logits.astype(jnp.float32), axis=0)
    lbs = jnp.concatenate([jnp.zeros_like(probs[0:1]), jnp.cumsum(probs, axis=0)[:-1]], axis=0)
    split_at = np.cumsum(IN_SIZES)[:-1].tolist()
    for l in range(DEPTH):
        hn = rmsnorm(h, norm_mix_w[l])
        proj = hn @ w_in[l]
        (q_sb, k_sb, v_sb, z_ssd, x_ssd, b_ssd, c_ssd, dt_ssd,
         q_hg, f_hg, i_hg, g_hg) = jnp.split(proj, split_at, axis=-1)
        o_sb = stick_breaking_group(q_sb, k_sb, v_sb, sb_q_norm[l], sb_k_norm[l], sb_out_norm[l], valid)
        o_ssd = ssd_group(z_ssd, x_ssd, b_ssd, c_ssd, dt_ssd, ssd_conv_w[l], ssd_conv_b[l], ssd_dt_bias[l],
                          ssd_A_log[l], ssd_D[l], ssd_norm_w[l], vmask)
        o_hg = hgrn2_group(q_hg, f_hg, i_hg, g_hg, lbs[l], hg_out_norm[l], valid)
        h = h + jnp.concatenate([o_sb, o_ssd, o_hg], axis=-1) @ w_out[l]
        hn = rmsnorm(h, norm_mlp_w[l])
        h = h + jnp.square(jax.nn.relu(hn @ w_up[l])) @ w_down[l]
    return h[:, CHUNK:]
```

```cpp
#include <hip/hip_runtime.h>
#include <hip/hip_cooperative_groups.h>
#include <cstdio>
#include <cstdint>
namespace cg = cooperative_groups;
namespace pg8 {
#define PG8_LAS __attribute__((address_space(3)))
typedef unsigned short bf16_t;
typedef short bf16x8 __attribute__((ext_vector_type(8)));
typedef float f32x4 __attribute__((ext_vector_type(4)));
typedef unsigned u32x4 __attribute__((ext_vector_type(4)));
constexpr int BM = 256, BK = 64, HALF = 128, HTB = HALF * BK * 2  , STAGE_BYTES = 8 * HTB, NXCD = 8, WGM = 8;

__host__ __device__ __forceinline__ int lds_byte(int r, int c) { const int st = (r >> 4) * 2 + (c >> 5), rr = r & 15, cc = c & 31, ob = rr * 64 + cc * 2; return st * 1024 + (ob ^ (((ob >> 9) & 1) << 5)); }
__host__ __device__ __forceinline__ void stage_rc(int b, int& R, int& C) { const int st = b / 1024, sb = b % 1024, swz = sb ^ (((sb >> 9) & 1) << 5); R = (st >> 1) * 16 + swz / 64; C = (st & 1) * 32 + (swz % 64) / 2; }
__host__ __device__ __forceinline__ int perm32(int rho) { const int n = rho >> 4, i = rho & 15; return 8 * (i >> 2) + 4 * n + (i & 3); }

struct Unit { int pm, pn; };
struct Gemm { const bf16_t* A; const bf16_t* Bt; int M, N, K; };

struct StaticOrder {
    int nM, nN, nwg, G, c;
    __host__ __device__ void init(int M, int N, int G_, int c_) { nM = M / BM; nN = N / BM; nwg = nM * nN; G = G_; c = c_; }
    __host__ __device__ bool next(int i, Unit& u) const {
        const long L = (long)i * G + c; if (L >= nwg) return false;
        int wgid = (int)L; { const int q = nwg / NXCD, r = nwg % NXCD, xcd = wgid % NXCD, off = wgid / NXCD; wgid = (xcd < r ? xcd * (q + 1) : r * (q + 1) + (xcd - r) * q) + off; }
        const int nig = WGM * nN, gid = wgid / nig, fm = gid * WGM, gsz = (nM - fm) < WGM ? (nM - fm) : WGM;
        u.pm = fm + ((wgid % nig) % gsz); u.pn = (wgid % nig) / gsz; return true;
    }
    __device__ __forceinline__ void a_ready(const Unit&) const {}
    __device__ __forceinline__ void done(const Unit&) const {}
};

typedef float f32x2_t __attribute__((ext_vector_type(2))); typedef __bf16 bf16x2_t __attribute__((ext_vector_type(2)));
typedef unsigned u32x2 __attribute__((ext_vector_type(2)));
__device__ __forceinline__ unsigned pk2(float lo, float hi) { f32x2_t v = {lo, hi}; bf16x2_t b = __builtin_convertvector(v, bf16x2_t); return __builtin_bit_cast(unsigned, b); }
constexpr float RMS_EPS = 1e-6f;

template <int ACT> struct EpiScale {
    static constexpr bool PERM = true, AFTER_DRAIN = false;
    bf16_t* O; int ldc; const float* ssq;
    __device__ __forceinline__ void operator()(const f32x4 (&acc)[2][2][4][2], const Unit& u, int wr, int wc, int fr, int fq) const {
        const int row0 = u.pm * BM + wr * 64 + fr; const int col0 = u.pn * BM + wc * 32 + 8 * fq;
        float rsv[2][4];
#pragma unroll
        for (int ai = 0; ai < 2; ++ai)
#pragma unroll
            for (int m = 0; m < 4; ++m) rsv[ai][m] = ssq[row0 + ai * HALF + m * 16];
#pragma unroll
        for (int ai = 0; ai < 2; ++ai)
#pragma unroll
            for (int m = 0; m < 4; ++m) { const int row = row0 + ai * HALF + m * 16;
                const float rs = __builtin_amdgcn_rsqf(rsv[ai][m] * (1.0f / 1024.0f) + RMS_EPS);
                bf16_t* rowp = O + (size_t)row * ldc + col0;
#pragma unroll
                for (int bj = 0; bj < 2; ++bj) { f32x4 v0 = acc[ai][bj][m][0] * rs, v1 = acc[ai][bj][m][1] * rs;
                    if (ACT == 1) {
#pragma unroll
                        for (int e = 0; e < 4; ++e) { float a = fmaxf(v0[e], 0.f), b = fmaxf(v1[e], 0.f); v0[e] = a * a; v1[e] = b * b; } }
                    u32x4 w; w.x = pk2(v0[0], v0[1]); w.y = pk2(v0[2], v0[3]); w.z = pk2(v1[0], v1[1]); w.w = pk2(v1[2], v1[3]);
                    *(u32x4*)(rowp + bj * HALF) = w; }
                if (m & 1) asm volatile("" ::: "memory"); }
    }
};
struct EpiResid {
    static constexpr bool PERM = false, AFTER_DRAIN = false;
    const float* smain; float* dmain; bf16_t* hb; float* ssq;
    __device__ __forceinline__ void operator()(const f32x4 (&acc)[2][2][4][2], const Unit& u, int wr, int wc, int fr, int fq) const {
        const int row0 = u.pm * BM + wr * 64 + fr; const int col0 = u.pn * BM + wc * 32 + 4 * fq;
#pragma unroll
        for (int ai = 0; ai < 2; ++ai)
#pragma unroll
            for (int m = 0; m < 4; ++m) { const int row = row0 + ai * HALF + m * 16;
                const float* sp = smain + (size_t)row * 1024;
                float* dp = dmain + (size_t)row * 1024;
                bf16_t* bp = hb + (size_t)row * 1024; float sq = 0.f;
#pragma unroll
                for (int bj = 0; bj < 2; ++bj)
#pragma unroll
                    for (int n = 0; n < 2; ++n) { const int c = col0 + bj * HALF + n * 16;
                        const f32x4 v = *(const f32x4*)(sp + c) + acc[ai][bj][m][n];
                        *(f32x4*)(dp + c) = v; sq += (v[0] * v[0] + v[1] * v[1]) + (v[2] * v[2] + v[3] * v[3]);
                        u32x2 w; w.x = pk2(v[0], v[1]); w.y = pk2(v[2], v[3]); *(u32x2*)(bp + c) = w; }
                sq += __shfl_xor(sq, 16); sq += __shfl_xor(sq, 32);
                if (fq == 0) atomicAdd(ssq + row, sq);
                if (m == 3) asm volatile("" ::: "memory"); }
    }
};

template <class Epi, class Sched, bool ALIGN_EPI = false, bool SP2 = false>
__device__ __forceinline__ void gemm_phase(PG8_LAS unsigned char* lds, const Gemm g, const Sched& S, const Epi& E) {
    int tid_ = threadIdx.x; asm volatile("" : "+v"(tid_));
    const int tid = tid_, wid = __builtin_amdgcn_readfirstlane(tid >> 6), lane = tid & 63, wr = wid >> 2, wc = wid & 3, fr = lane & 15, fq = lane >> 4;
    const int K = g.K, nt = K / BK;
    unsigned voffA[2], voffB[2];
#pragma unroll
    for (int i = 0; i < 2; ++i) { int R, C; stage_rc(tid * 16 + i * 8192, R, C); const int Rb = Epi::PERM ? ((R & ~31) + perm32(R & 31)) : R;
        voffA[i] = (unsigned)(R * K + C) * 2u; voffB[i] = (unsigned)(Rb * K + C) * 2u; }
    const size_t kstep = (size_t)(BK * 2);
    const size_t hstep = (size_t)HALF * K * 2;
    const size_t tstep = 2 * hstep;
    const unsigned ldsw = (unsigned)wid * 1024u;
    const int aoff = lds_byte(wr * 64 + fr, fq * 8), boff = lds_byte(wc * 32 + fr, fq * 8);
#define PG8_SA(b, h) (((b) * 2 + (h)) * HTB)
#define PG8_SB(b, h) ((4 + (b) * 2 + (h)) * HTB)
#define PG8_STAGE(bufoff, gbase, voff) do { _Pragma("unroll") for (int _i = 0; _i < 2; ++_i) \
        __builtin_amdgcn_global_load_lds((const unsigned*)((const char*)(gbase) + (voff)[_i]), (PG8_LAS unsigned*)(lds + (bufoff) + ldsw + _i * 8192), 16, 0, 0); } while (0)
#define PG8_LDA(dst, b, h) do { _Pragma("unroll") for (int m = 0; m < 4; ++m) _Pragma("unroll") for (int k = 0; k < 2; ++k) dst[m][k] = *(const PG8_LAS bf16x8*)(lds + PG8_SA(b, h) + aoff + m * 2048 + k * 1024); } while (0)
#define PG8_LDB(dst, b, h) do { _Pragma("unroll") for (int n = 0; n < 2; ++n) _Pragma("unroll") for (int k = 0; k < 2; ++k) dst[n][k] = *(const PG8_LAS bf16x8*)(lds + PG8_SB(b, h) + boff + n * 2048 + k * 1024); } while (0)
#define PG8_MMA(ai, bj, At, Bt) do { __builtin_amdgcn_s_setprio(1); _Pragma("unroll") for (int m = 0; m < 4; ++m) _Pragma("unroll") for (int n = 0; n < 2; ++n) _Pragma("unroll") for (int k = 0; k < 2; ++k) \
        acc[ai][bj][m][n] = __builtin_amdgcn_mfma_f32_16x16x32_bf16(Bt[n][k], At[m][k], acc[ai][bj][m][n], 0, 0, 0); __builtin_amdgcn_s_setprio(0); } while (0)
#define PG8_WAIT_V(n) asm volatile("s_waitcnt vmcnt(" #n ")" ::: "memory")
#define PG8_WAIT_L(n) asm volatile("s_waitcnt lgkmcnt(" #n ")" ::: "memory")
#define PG8_BAR __builtin_amdgcn_s_barrier()
#define PG8_SCHED __builtin_amdgcn_sched_barrier(0)
    Unit cur, nxt; int ui = 0;
    if (!S.next(0, cur)) return;
    f32x4 acc[2][2][4][2];
#pragma unroll
    for (int a = 0; a < 2; ++a)
#pragma unroll
        for (int b = 0; b < 2; ++b)
#pragma unroll
            for (int m = 0; m < 4; ++m)
#pragma unroll
                for (int n = 0; n < 2; ++n) acc[a][b][m][n] = (f32x4){0.f, 0.f, 0.f, 0.f};
    bf16x8 At[4][2], B0[2][2], B1[2][2];
    const char* cA = (const char*)g.A + (size_t)cur.pm * tstep; const char* cB = (const char*)g.Bt + (size_t)cur.pn * tstep;
    S.a_ready(cur);
    if constexpr (SP2) {
        PG8_STAGE(PG8_SB(0, 0), cB, voffB); PG8_STAGE(PG8_SB(0, 1), cB + hstep, voffB); PG8_STAGE(PG8_SA(0, 0), cA, voffA); PG8_STAGE(PG8_SA(0, 1), cA + hstep, voffA);
        if (wr == 1) PG8_BAR;
        PG8_WAIT_V(2); PG8_BAR;
        PG8_STAGE(PG8_SB(1, 0), cB + kstep, voffB); PG8_STAGE(PG8_SA(1, 0), cA + kstep, voffA); PG8_STAGE(PG8_SB(1, 1), cB + hstep + kstep, voffB);
        PG8_WAIT_V(6); PG8_BAR;
    } else {
        PG8_STAGE(PG8_SB(0, 0), cB, voffB); PG8_STAGE(PG8_SA(0, 0), cA, voffA); PG8_STAGE(PG8_SB(0, 1), cB + hstep, voffB); PG8_STAGE(PG8_SA(0, 1), cA + hstep, voffA);
        if (wr == 1) PG8_BAR;
        PG8_WAIT_V(4); PG8_BAR;
        PG8_STAGE(PG8_SB(1, 0), cB + kstep, voffB); PG8_STAGE(PG8_SA(1, 0), cA + kstep, voffA); PG8_STAGE(PG8_SB(1, 1), cB + hstep + kstep, voffB);
        PG8_WAIT_V(6); PG8_BAR;
    }
    for (;;) {
        const bool has_next = S.next(ui + 1, nxt);
        const char* nA = has_next ? (const char*)g.A + (size_t)nxt.pm * tstep : cA; const char* nB = has_next ? (const char*)g.Bt + (size_t)nxt.pn * tstep : cB;
        for (int t = 0; t < nt; t += 2) {
            const bool last = (t == nt - 2);
            const char* a1 = cA + (size_t)(t + 1) * kstep;
            const char* a2 = last ? nA : cA + (size_t)(t + 2) * kstep; const char* b2 = last ? nB : cB + (size_t)(t + 2) * kstep;
            const char* a3 = a2 + kstep; const char* b3 = b2 + kstep;
            if (last && has_next) S.a_ready(nxt);
            if constexpr (SP2) {
            PG8_LDB(B0, 0, 0); PG8_LDB(B1, 0, 1); PG8_SCHED; PG8_LDA(At, 0, 0); PG8_STAGE(PG8_SA(1, 1), a1 + hstep, voffA);
            PG8_WAIT_V(8); PG8_WAIT_L(0); PG8_BAR; PG8_MMA(0, 0, At, B0); PG8_MMA(0, 1, At, B1); PG8_BAR; PG8_SCHED;
            PG8_LDA(At, 0, 1); PG8_STAGE(PG8_SB(0, 0), b2, voffB); PG8_STAGE(PG8_SB(0, 1), b2 + hstep, voffB); PG8_STAGE(PG8_SA(0, 0), a2, voffA);
            PG8_WAIT_V(8); PG8_WAIT_L(0); PG8_BAR; PG8_MMA(1, 0, At, B0); PG8_MMA(1, 1, At, B1); PG8_BAR; PG8_SCHED;
            PG8_LDB(B0, 1, 0); PG8_LDB(B1, 1, 1); PG8_SCHED; PG8_LDA(At, 1, 0); PG8_STAGE(PG8_SA(0, 1), a2 + hstep, voffA);
            PG8_WAIT_V(8); PG8_WAIT_L(0); PG8_BAR; PG8_MMA(0, 0, At, B0); PG8_MMA(0, 1, At, B1); PG8_BAR; PG8_SCHED;
            PG8_LDA(At, 1, 1); PG8_STAGE(PG8_SB(1, 0), b3, voffB); PG8_STAGE(PG8_SB(1, 1), b3 + hstep, voffB); PG8_STAGE(PG8_SA(1, 0), a3, voffA);
            PG8_WAIT_V(8); PG8_WAIT_L(0); PG8_BAR; PG8_MMA(1, 0, At, B0); PG8_MMA(1, 1, At, B1); PG8_BAR; PG8_SCHED;
            } else {
            PG8_LDB(B0, 0, 0); PG8_SCHED; PG8_LDA(At, 0, 0); PG8_STAGE(PG8_SA(1, 1), a1 + hstep, voffA);
            PG8_WAIT_L(8); PG8_BAR; PG8_WAIT_L(0); PG8_MMA(0, 0, At, B0); PG8_BAR; PG8_SCHED;
            PG8_LDB(B1, 0, 1); PG8_STAGE(PG8_SB(0, 0), b2, voffB);
            PG8_BAR; PG8_WAIT_L(0); PG8_MMA(0, 1, At, B1); PG8_BAR;
            PG8_LDA(At, 0, 1); PG8_STAGE(PG8_SA(0, 0), a2, voffA);
            PG8_BAR; PG8_WAIT_L(0); PG8_MMA(1, 0, At, B0); PG8_BAR; PG8_SCHED;
            PG8_STAGE(PG8_SB(0, 1), b2 + hstep, voffB);
            PG8_WAIT_V(6); PG8_BAR; PG8_MMA(1, 1, At, B1); PG8_BAR;
            PG8_LDB(B0, 1, 0); PG8_SCHED; PG8_LDA(At, 1, 0); PG8_STAGE(PG8_SA(0, 1), a2 + hstep, voffA);
            PG8_WAIT_L(8); PG8_BAR; PG8_WAIT_L(0); PG8_MMA(0, 0, At, B0); PG8_BAR; PG8_SCHED;
            PG8_LDB(B1, 1, 1); PG8_STAGE(PG8_SB(1, 0), b3, voffB);
            PG8_BAR; PG8_WAIT_L(0); PG8_MMA(0, 1, At, B1); PG8_BAR;
            PG8_LDA(At, 1, 1); PG8_STAGE(PG8_SA(1, 0), a3, voffA);
            PG8_BAR; PG8_WAIT_L(0); PG8_MMA(1, 0, At, B0); PG8_BAR; PG8_SCHED;
            PG8_STAGE(PG8_SB(1, 1), b3 + hstep, voffB);
            PG8_WAIT_V(6); PG8_BAR; PG8_MMA(1, 1, At, B1); PG8_BAR;
            }
        }
        if constexpr (ALIGN_EPI) { if (wr == 0) PG8_BAR; }
        if constexpr (!Epi::AFTER_DRAIN) { E(acc, cur, wr, wc, fr, fq); S.done(cur); }
        if (!has_next) break;
#pragma unroll
        for (int a = 0; a < 2; ++a)
#pragma unroll
            for (int b = 0; b < 2; ++b)
#pragma unroll
                for (int m = 0; m < 4; ++m)
#pragma unroll
                    for (int n = 0; n < 2; ++n) acc[a][b][m][n] = (f32x4){0.f, 0.f, 0.f, 0.f};
        cur = nxt; cA = nA; cB = nB; ++ui;
        if constexpr (ALIGN_EPI) { if (wr == 1) PG8_BAR; }
    }
    PG8_WAIT_V(0);
    if constexpr (!ALIGN_EPI) { if (wr == 0) PG8_BAR; }
    PG8_BAR;
    if constexpr (Epi::AFTER_DRAIN) { E.fused(acc, cur, wr, wc, fr, fq, lds, wid, lane); S.done(cur); }
#undef PG8_SA
#undef PG8_SB
#undef PG8_STAGE
#undef PG8_LDA
#undef PG8_LDB
#undef PG8_MMA
#undef PG8_WAIT_V
#undef PG8_WAIT_L
#undef PG8_BAR
#undef PG8_SCHED
}
}
#define DI __device__ __forceinline__
#define LAS __attribute__((address_space(3)))
typedef LAS unsigned char* ldsp;
typedef unsigned short bf16;
typedef short bf16x8 __attribute__((ext_vector_type(8)));
typedef short s16x4 __attribute__((ext_vector_type(4)));
typedef float f32x16 __attribute__((ext_vector_type(16)));
typedef float f32x4 __attribute__((ext_vector_type(4)));
typedef unsigned u32x4 __attribute__((ext_vector_type(4)));
typedef unsigned u32x2 __attribute__((ext_vector_type(2)));
using pg8::pk2;

constexpr int NB = 8, SEQ = 4096, DM = 1024, DFF = 4096, MMAIN = NB * SEQ, MROWS = MMAIN + 32, LEADROW = MMAIN + 16;
constexpr int LDP = 3584;
constexpr int DIN = 3336;
constexpr int NPAD = 112;
constexpr int C_QSB = 0, C_KSB = 256, C_VSB = 512, C_Z = 768, C_X = 1280, C_B = 1792, C_C = 2048, C_QHG = 2304, C_FHG = 2560, C_IHG = 2816, C_GHG = 3072, C_DT = 3328;
constexpr float EPS = 1e-6f;

constexpr size_t MiB = 1u << 20;
constexpr size_t WS_W = 2 * MiB, W_LAYER = 25 * MiB, W_IN = 0, W_OUT = 7 * MiB, W_UP = 9 * MiB, W_DOWN = 17 * MiB;
constexpr size_t WS_HLEAD = 52 * MiB, WS_SSQA = 56 * MiB, WS_SSQB = 57 * MiB, WS_HB = 58 * MiB, WS_PROJ = 124 * MiB, WS_MIX = 355 * MiB, WS_HID = 124 * MiB, WS_SSDE = 421 * MiB, WS_HGE = 437 * MiB, WS_HGD = 445 * MiB, WS_SEGD = 453 * MiB, WS_BLOB2 = 454 * MiB, WS_BLOB1 = WS_HB  , WS_CTL = 0, WS_END = 504 * MiB;
constexpr int NSEG = 8, NSEG_HG = 16;
constexpr int LDS_BYTES = 147456 + 64;
constexpr int LDS_BAR = 147456;
constexpr int CW_BAR = 4096;

struct Params { const float* in[19]; float* out; unsigned char* ws; };
enum { I_X = 0, I_META, I_LBL, I_NMIX, I_WIN, I_QN, I_KN, I_SBON, I_CONVW, I_CONVB, I_DTB, I_ALOG, I_D, I_SSDNW, I_HGON, I_WOUT, I_NMLP, I_WUP, I_WDOWN };

DI float bflo(unsigned w) { return __uint_as_float(w << 16); }
DI float bfhi(unsigned w) { return __uint_as_float(w & 0xffff0000u); }
DI float bf2f(unsigned short b) { return __uint_as_float(((unsigned)b) << 16); }
DI unsigned short f2bf1(float f) { return (unsigned short)(pk2(f, 0.f) & 0xffffu); }
DI float fexp(float x) { return __builtin_amdgcn_exp2f(x * 1.4426950408889634f); }
DI float flog(float x) { return __builtin_amdgcn_logf(x) * 0.6931471805599453f; }
DI int crow(int i, int h) { return (i & 3) + 8 * (i >> 2) + 4 * h; }
DI size_t rowof(int b, int t) { return t < 128 ? (size_t)(MMAIN + (t - 96)) : (size_t)(b * 4096 + (t - 128)); }
DI float wave_sum(float v) {
#pragma unroll
    for (int o = 1; o < 64; o <<= 1) v += __shfl_xor(v, o);
    return v;
}
#define MFMA32(a, b, c) __builtin_amdgcn_mfma_f32_32x32x16_bf16((a), (b), (c), 0, 0, 0)
template <int S> DI bf16x8 pack8(const f32x16& x) {
    u32x4 p; p[0] = pk2(x[8 * S + 0], x[8 * S + 1]); p[1] = pk2(x[8 * S + 2], x[8 * S + 3]); p[2] = pk2(x[8 * S + 4], x[8 * S + 5]); p[3] = pk2(x[8 * S + 6], x[8 * S + 7]);
    return __builtin_bit_cast(bf16x8, p);
}
DI bf16x8 lds_frag16(ldsp p) { return *(const LAS bf16x8*)p; }
DI bf16x8 lds_frag_perm(ldsp p) {
    const s16x4 lo = *(const LAS s16x4*)p; const s16x4 hi = *(const LAS s16x4*)(p + 16);
    return __builtin_shufflevector(lo, hi, 0, 1, 2, 3, 4, 5, 6, 7);
}
typedef short v4i16_t __attribute__((ext_vector_type(4)));
DI bf16x8 lds_frag_tr(ldsp img, int pitch, int k0, int m0, int lane) {
    const int i16 = lane & 15, q = i16 >> 2, p = i16 & 3, blk = (lane >> 4) & 1;
    ldsp a = img + (k0 + q) * pitch + (m0 + 16 * blk + 4 * p) * 2;
    const s16x4 lo = __builtin_bit_cast(s16x4, __builtin_amdgcn_ds_read_tr16_b64_v4i16((LAS v4i16_t*)a));
    const s16x4 hi = __builtin_bit_cast(s16x4, __builtin_amdgcn_ds_read_tr16_b64_v4i16((LAS v4i16_t*)(a + 4 * pitch)));
    return __builtin_shufflevector(lo, hi, 0, 1, 2, 3, 4, 5, 6, 7);
}
DI f32x16 zero16() { f32x16 z;
#pragma unroll
    for (int i = 0; i < 16; ++i) z[i] = 0.f;
    return z; }

#define XB_TMO      128
#define XB_XCNT(j)  (256  + 64 * (j))
#define XB_XSUB(j)  (1280 + 64 * (j))
#define XB_XGEN(j)  (2304 + 64 * (j))
#define XB_TOP      3328
#define XB_TOPGEN   3392
#define XCD_BAR_WORDS 3456
#define XB_SPIN_CAP (1u << 18)

__device__ __forceinline__ unsigned xb_ld(unsigned* p)              { return __hip_atomic_load(p, __ATOMIC_RELAXED, __HIP_MEMORY_SCOPE_AGENT); }
__device__ __forceinline__ unsigned xb_add(unsigned* p, unsigned v) { return __hip_atomic_fetch_add(p, v, __ATOMIC_RELAXED, __HIP_MEMORY_SCOPE_AGENT); }
__device__ __forceinline__ unsigned xb_xcc_id() { return (unsigned)__builtin_amdgcn_s_getreg((3 << 11) | 20) & 0xFu; }
#define XB_SPIN(cond, bar) do { unsigned _sp = 0; while (cond) { __builtin_amdgcn_s_sleep(1); \
    if ((++_sp & 255u) == 0u) { if (xb_ld(&(bar)[XB_TMO])) break; if (_sp > XB_SPIN_CAP) { atomicAdd(&(bar)[XB_TMO], 1u); break; } } } } while (0)

struct XcdBarrier {
    unsigned* bar; unsigned x;
    volatile LAS unsigned* st;
};
__device__ __forceinline__ XcdBarrier xcd_barrier_post(unsigned* bar, volatile LAS unsigned* st) {
    XcdBarrier b; b.bar = bar; b.x = xb_xcc_id(); b.st = st;
    if (threadIdx.x == 0) (void)xb_add(&bar[XB_XCNT(b.x)], 1u);
    return b;
}
__device__ __forceinline__ void xcd_barrier_complete(unsigned* bar, unsigned x, unsigned& nloc, unsigned& nx) {
    const unsigned G = gridDim.x * gridDim.y * gridDim.z;
    unsigned sum, cnt, mine, sp = 0u;
    for (;;) {
        sum = 0u; cnt = 0u; mine = 0u;
#pragma unroll
        for (unsigned j = 0; j < 16; ++j) { const unsigned c = xb_ld(&bar[XB_XCNT(j)]); sum += c; cnt += (c > 0u) ? 1u : 0u; mine = (j == x) ? c : mine; }
        if (sum == G) break;
        __builtin_amdgcn_s_sleep(1);
        if ((++sp & 255u) == 0u) { if (xb_ld(&bar[XB_TMO])) break; if (sp > XB_SPIN_CAP) { atomicAdd(&bar[XB_TMO], 1u); break; } }
    }
    nloc = mine > 0u ? mine : 1u; nx = cnt > 0u ? cnt : 1u;
}

__device__ __forceinline__ void xcd_barrier(const XcdBarrier& b) {
    asm volatile("s_waitcnt vmcnt(0)" ::: "memory");
    __syncthreads();
    if (threadIdx.x == 0) {
        unsigned* bar = b.bar;
        __builtin_amdgcn_s_waitcnt(0);
        unsigned nloc = b.st[0], nx = b.st[1];
        if (nloc == 0u) { xcd_barrier_complete(bar, b.x, nloc, nx); b.st[0] = nloc; b.st[1] = nx; }
        const unsigned old = xb_add(&bar[XB_XSUB(b.x)], 1u);
        const unsigned gen = old / nloc;
        if (old + 1u == (gen + 1u) * nloc) {
            __builtin_amdgcn_fence(__ATOMIC_RELEASE, "agent");
            asm volatile("s_waitcnt vmcnt(0)" ::: "memory");
            const unsigned og = xb_add(&bar[XB_TOP], 1u);
            const unsigned tg = og / nx;
            if (og + 1u == (tg + 1u) * nx) xb_add(&bar[XB_TOPGEN], 1u);
            else XB_SPIN(xb_ld(&bar[XB_TOPGEN]) == tg, bar);
            __builtin_amdgcn_fence(__ATOMIC_ACQUIRE, "agent");
            xb_add(&bar[XB_XGEN(b.x)], 1u);
            asm volatile("s_waitcnt vmcnt(0)" ::: "memory");
        } else {
            XB_SPIN(xb_ld(&bar[XB_XGEN(b.x)]) == gen, bar);
            __builtin_amdgcn_fence(__ATOMIC_ACQUIRE, "agent");
            asm volatile("s_waitcnt vmcnt(0)" ::: "memory");
        }
    }
    __syncthreads();
}

DI void transpose_item(const float* W, int K, int Nsrc, bf16* WT, const float* kscale, int mode, LAS float* scr, int item, int nblk, int lane) {
    const int kb = item / nblk, nb = item % nblk, k0 = 64 * kb, n0 = 32 * nb;
    const int nn = n0 + (lane & 31); int src = nn; bool ok = true;
    if (mode == 1) { if (nn < 2304) src = nn; else if (nn < 3328) src = nn + 8; else if (nn < 3336) src = nn - 3328 + 2304; else { ok = false; src = 0; } }
    float wv[32];
#pragma unroll
    for (int i = 0; i < 32; ++i) { const int kk = 2 * i + (lane >> 5); wv[i] = ok ? W[(size_t)(k0 + kk) * Nsrc + src] : 0.f; }
#pragma unroll
    for (int i = 0; i < 32; ++i) { const int kk = 2 * i + (lane >> 5); float v = wv[i]; if (kscale) v *= kscale[k0 + kk]; scr[kk * 33 + (lane & 31)] = v; }
    asm volatile("s_waitcnt lgkmcnt(0)" ::: "memory");
    const int c = lane & 7;
#pragma unroll
    for (int j = 0; j < 4; ++j) { const int n = (lane >> 3) + 8 * j; const LAS float* s = scr + (8 * c) * 33 + n;
        u32x4 o; o.x = pk2(s[0 * 33], s[1 * 33]); o.y = pk2(s[2 * 33], s[3 * 33]); o.z = pk2(s[4 * 33], s[5 * 33]); o.w = pk2(s[6 * 33], s[7 * 33]);
        *(u32x4*)(WT + (size_t)(n0 + n) * K + k0 + 8 * c) = o; }
    asm volatile("s_waitcnt lgkmcnt(0)" ::: "memory");
}

constexpr int I_IN = 16 * 112, I_OUT = 16 * 32, I_UP = 16 * 128, I_DN = 64 * 32, I_LAYER = I_IN + I_OUT + I_UP + I_DN;
DI void convert_item(const Params& P, LAS float* scr, int it, int lane) {
    const int l = it / I_LAYER; int r = it % I_LAYER;
    unsigned char* wb = P.ws + WS_W + (size_t)l * W_LAYER;
    if (r < I_IN) { transpose_item(P.in[I_WIN] + (size_t)l * DM * DIN, DM, DIN, (bf16*)(wb + W_IN), P.in[I_NMIX] + l * DM, 1, scr, r, 112, lane); return; } r -= I_IN;
    if (r < I_OUT) { transpose_item(P.in[I_WOUT] + (size_t)l * DM * DM, DM, DM, (bf16*)(wb + W_OUT), nullptr, 0, scr, r, 32, lane); return; } r -= I_OUT;
    if (r < I_UP) { transpose_item(P.in[I_WUP] + (size_t)l * DM * DFF, DM, DFF, (bf16*)(wb + W_UP), P.in[I_NMLP] + l * DM, 0, scr, r, 128, lane); return; } r -= I_UP;
    transpose_item(P.in[I_WDOWN] + (size_t)l * DFF * DM, DFF, DM, (bf16*)(wb + W_DOWN), nullptr, 0, scr, r, 32, lane);
}
DI void convert_dynamic(const Params& P, ldsp L) {
    int t = threadIdx.x; asm volatile("" : "+v"(t)); const int lane = t & 63, wave = __builtin_amdgcn_readfirstlane(t >> 6);
    unsigned* ctr = (unsigned*)(P.ws + WS_CTL) + 64 * 2;
    LAS float* scr = (LAS float*)(L + 65536 + wave * 8704);
    for (;;) {
        unsigned u = 0u; if (lane == 0) u = atomicAdd(ctr, 4u);
        u = (unsigned)__builtin_amdgcn_readfirstlane((int)u);
        if (u >= (unsigned)I_LAYER) break;
        for (int k = 0; k < 4; ++k) if (u + k < (unsigned)I_LAYER) convert_item(P, scr, I_LAYER + (int)(u + k), lane);
    }
}
DI void prologue(const Params& P, ldsp L, int tid, int lane, int wave) {
    LAS float* scr = (LAS float*)(L + wave * 16384);
    const int gw = blockIdx.x * 8 + wave, NGW = gridDim.x * 8;
    for (int it = gw; it < I_LAYER; it += NGW) convert_item(P, scr, it, lane);
    float* hlead = (float*)(P.ws + WS_HLEAD); float* ssqA = (float*)(P.ws + WS_SSQA); bf16* hb = (bf16*)(P.ws + WS_HB);
    for (int row0 = gw; row0 < MMAIN + 16; row0 += 4 * NGW) {
        f32x4 v[4][4];
#pragma unroll
        for (int rr = 0; rr < 4; ++rr) { const int row = row0 + rr * NGW;
            if (row < MMAIN + 16) { const float* src = row < MMAIN ? P.in[I_X] + (size_t)row * DM : P.in[I_META] + (size_t)(row - MMAIN) * DM;
#pragma unroll
                for (int j = 0; j < 4; ++j) v[rr][j] = ((const f32x4*)src)[lane + 64 * j]; } }
#pragma unroll
        for (int rr = 0; rr < 4; ++rr) { const int row = row0 + rr * NGW;
            if (row < MMAIN + 16) {
                const int orow = row < MMAIN ? row : row + 16;
                float ss = 0.f;
#pragma unroll
                for (int j = 0; j < 4; ++j) ss += (v[rr][j][0] * v[rr][j][0] + v[rr][j][1] * v[rr][j][1]) + (v[rr][j][2] * v[rr][j][2] + v[rr][j][3] * v[rr][j][3]);
                ss = wave_sum(ss);
                if (row >= MMAIN) {
#pragma unroll
                    for (int j = 0; j < 4; ++j) ((f32x4*)(hlead + (size_t)(row - MMAIN) * DM))[lane + 64 * j] = v[rr][j]; }
#pragma unroll
                for (int j = 0; j < 4; ++j) { u32x2 w; w.x = pk2(v[rr][j][0], v[rr][j][1]); w.y = pk2(v[rr][j][2], v[rr][j][3]); ((u32x2*)(hb + (size_t)orow * DM))[lane + 64 * j] = w; }
                if (lane == 0) ssqA[orow] = ss; } }
    }
}

template <int MODE>
DI void lead_gemm(ldsp L, const bf16* A, const bf16* Wt, int N, int K, bf16* O, int ldo, const float* ssq_in, float* hlead, float* ssq_out) {
    int t = threadIdx.x; asm volatile("" : "+v"(t));
    const int lane = t & 63, wave = __builtin_amdgcn_readfirstlane(t >> 6), i = lane & 15, q = lane >> 4;
    int bx = blockIdx.x; asm volatile("" : "+s"(bx));
    const int ks = K >> 3;
    for (int tile = bx; tile < N / 16; tile += (int)gridDim.x) {
        const int n0 = tile * 16;
        const bf16* ap = A + (size_t)i * K + wave * ks + 8 * q; const bf16* bp = Wt + (size_t)(n0 + i) * K + wave * ks + 8 * q;
        f32x4 acc = {0.f, 0.f, 0.f, 0.f};
#pragma unroll 8
        for (int kk = 0; kk < ks; kk += 32) { const bf16x8 a = *(const bf16x8*)(ap + kk); const bf16x8 bb = *(const bf16x8*)(bp + kk); acc = __builtin_amdgcn_mfma_f32_16x16x32_bf16(a, bb, acc, 0, 0, 0); }
        *(LAS f32x4*)(L + (wave * 64 + lane) * 16) = acc;
        __syncthreads();
        if (wave == 0) {
#pragma unroll
            for (int w2 = 1; w2 < 8; ++w2) acc += *(const LAS f32x4*)(L + (w2 * 64 + lane) * 16);
#pragma unroll
            for (int j = 0; j < 4; ++j) { const int row = 4 * q + j;
                if (MODE == 2) { float* hp = hlead + (size_t)row * DM + n0 + i; const float v = *hp + acc[j]; *hp = v; O[(size_t)row * ldo + n0 + i] = f2bf1(v);
                    float sq = v * v; sq += __shfl_xor(sq, 1); sq += __shfl_xor(sq, 2); sq += __shfl_xor(sq, 4); sq += __shfl_xor(sq, 8);
                    if (i == 0) atomicAdd(ssq_out + row, sq); }
                else { const float rs = __builtin_amdgcn_rsqf(ssq_in[row] * (1.f / 1024.f) + EPS); float v = acc[j] * rs; if (MODE == 1) { v = fmaxf(v, 0.f); v = v * v; }
                    O[(size_t)row * ldo + n0 + i] = f2bf1(v); } }
        }
        __syncthreads();
    }
}

constexpr int VT_PITCH = 80;
DI void sb_unit(const Params& P, int layer, ldsp WL, int b, int hd, int qblk, int lane_) {
    int lane = lane_; asm volatile("" : "+v"(lane));
    const int r = lane & 31, h = lane >> 5;
    const bf16* proj = (const bf16*)(P.ws + WS_PROJ); bf16* mix = (bf16*)(P.ws + WS_MIX);
    const int t0 = qblk * 32, tq = t0 + r;
    const size_t rowq = rowof(b, tq);
    bf16* mixrow = mix + rowq * DM;
    const float* qn = P.in[I_QN] + layer * 64; const float* kn = P.in[I_KN] + layer * 64;
    u32x4 kraw[4], vraw[4], kn1[4], vn1[4];
    { const size_t rowk = rowof(b, 32 * qblk + r); const bf16* kp = proj + rowk * LDP + C_KSB + hd * 64; const bf16* vp = proj + rowk * LDP + C_VSB + hd * 64;
#pragma unroll
      for (int kk = 0; kk < 4; ++kk) { kraw[kk] = *(const u32x4*)(kp + 16 * kk + 8 * h); vraw[kk] = *(const u32x4*)(vp + 16 * kk + 8 * h); } }
    { const int kt1 = qblk > 3 ? qblk - 1 : 3; const size_t rowk = rowof(b, 32 * kt1 + r); const bf16* kp = proj + rowk * LDP + C_KSB + hd * 64; const bf16* vp = proj + rowk * LDP + C_VSB + hd * 64;
#pragma unroll
      for (int kk = 0; kk < 4; ++kk) { kn1[kk] = *(const u32x4*)(kp + 16 * kk + 8 * h); vn1[kk] = *(const u32x4*)(vp + 16 * kk + 8 * h); } }
    bf16x8 qf[4];
    {
        const bf16* qp = proj + rowq * LDP + C_QSB + hd * 64;
        u32x4 raw[4]; float ss = 0.f; f32x4 gq[4][2], gk[4][2];
#pragma unroll
        for (int kk = 0; kk < 4; ++kk) { raw[kk] = *(const u32x4*)(qp + 16 * kk + 8 * h);
            gq[kk][0] = *(const f32x4*)(qn + 16 * kk + 8 * h); gq[kk][1] = *(const f32x4*)(qn + 16 * kk + 8 * h + 4); gk[kk][0] = *(const f32x4*)(kn + 16 * kk + 8 * h); gk[kk][1] = *(const f32x4*)(kn + 16 * kk + 8 * h + 4); }
#pragma unroll
        for (int kk = 0; kk < 4; ++kk)
#pragma unroll
            for (int e = 0; e < 4; ++e) { const float a = bflo(raw[kk][e]), c = bfhi(raw[kk][e]); ss += a * a + c * c; }
        ss += __shfl_xor(ss, 32);
        const float rs = __builtin_amdgcn_rsqf(ss * (1.f / 64.f) + EPS) * (0.125f * 1.4426950408889634f);
#pragma unroll
        for (int kk = 0; kk < 4; ++kk) { u32x4 p;
#pragma unroll
            for (int e = 0; e < 4; ++e) { const float g0 = gq[kk][e >> 1][(2 * e) & 3] * gk[kk][e >> 1][(2 * e) & 3], g1 = gq[kk][e >> 1][(2 * e + 1) & 3] * gk[kk][e >> 1][(2 * e + 1) & 3]; p[e] = pk2(bflo(raw[kk][e]) * rs * g0, bfhi(raw[kk][e]) * rs * g1); }
            qf[kk] = __builtin_bit_cast(bf16x8, p); }
    }
    bf16x8 T0, T1;
#pragma unroll
    for (int j = 0; j < 8; ++j) { const int k0 = 8 * (j >> 2) + 4 * h + (j & 3); T0[j] = (k0 > r) ? (short)0x3F80 : (short)0; T1[j] = (16 + k0 > r) ? (short)0x3F80 : (short)0; }
    float R = 0.f; f32x16 o0 = zero16(), o1 = zero16();
    for (int kt = qblk; kt >= 3; --kt) {
#pragma unroll
        for (int kk = 0; kk < 4; ++kk)
#pragma unroll
            for (int e = 0; e < 4; ++e) { const int d = 16 * kk + 8 * h + 2 * e;
                *(LAS unsigned short*)(WL + d * VT_PITCH + r * 2) = (unsigned short)(vraw[kk][e] & 0xffffu);
                *(LAS unsigned short*)(WL + (d + 1) * VT_PITCH + r * 2) = (unsigned short)(vraw[kk][e] >> 16); }
        bf16x8 kf[4];
        { float ss = 0.f;
#pragma unroll
            for (int kk = 0; kk < 4; ++kk) { kf[kk] = __builtin_bit_cast(bf16x8, kraw[kk]);
#pragma unroll
                for (int e = 0; e < 4; ++e) { const float a = bflo(kraw[kk][e]), c = bfhi(kraw[kk][e]); ss += a * a + c * c; } }
            ss += __shfl_xor(ss, 32);
            *(LAS float*)(WL + 5120 + r * 4) = __builtin_amdgcn_rsqf(ss * (1.f / 64.f) + EPS); }
        {
            const int kt2 = kt - 2 >= 3 ? kt - 2 : 3;
            const size_t rowk = rowof(b, 32 * kt2 + r); const bf16* kp = proj + rowk * LDP + C_KSB + hd * 64; const bf16* vp = proj + rowk * LDP + C_VSB + hd * 64;
#pragma unroll
            for (int kk = 0; kk < 4; ++kk) { kraw[kk] = kn1[kk]; vraw[kk] = vn1[kk]; kn1[kk] = *(const u32x4*)(kp + 16 * kk + 8 * h); vn1[kk] = *(const u32x4*)(vp + 16 * kk + 8 * h); } }
        f32x16 zt = zero16();
#pragma unroll
        for (int kk = 0; kk < 4; ++kk) zt = MFMA32(kf[kk], qf[kk], zt);
        f32x16 lk, lh, ll; float tot = 0.f; unsigned vmask = 0u;
#pragma unroll
        for (int i = 0; i < 16; ++i) { const int ka = 32 * kt + crow(i, h); const bool valid = (ka < tq) && (ka >= NPAD); vmask |= valid ? (1u << i) : 0u;
            const float z = zt[i] * *(const LAS float*)(WL + 5120 + crow(i, h) * 4); const float e = __builtin_amdgcn_exp2f(-fabsf(z)); const float l = __builtin_amdgcn_logf(1.f + e);
            const float ls = fminf(z, 0.f) - l;
            const float lkv = valid ? (fminf(-z, 0.f) - l) : 0.f;
            lk[i] = lkv; tot += lkv; zt[i] = ls; }
#pragma unroll
        for (int i = 0; i < 16; i += 2) { const unsigned ph = pk2(lk[i], lk[i + 1]); lh[i] = bflo(ph); lh[i + 1] = bfhi(ph); ll[i] = lk[i] - lh[i]; ll[i + 1] = lk[i + 1] - lh[i + 1]; }
        f32x16 st = zero16();
        st = MFMA32(T0, pack8<0>(lh), st); st = MFMA32(T1, pack8<1>(lh), st); st = MFMA32(T0, pack8<0>(ll), st); st = MFMA32(T1, pack8<1>(ll), st);
        f32x16 wv;
#pragma unroll
        for (int i = 0; i < 16; ++i) { const float lw = zt[i] + st[i] + R; wv[i] = ((vmask >> i) & 1u) ? __builtin_amdgcn_exp2f(lw) : 0.f; }
        const bf16x8 wb0 = pack8<0>(wv), wb1 = pack8<1>(wv);
        {
            const bf16x8 a00 = lds_frag_perm(WL + r * VT_PITCH + (4 * h) * 2), a01 = lds_frag_perm(WL + r * VT_PITCH + (16 + 4 * h) * 2);
            const bf16x8 a10 = lds_frag_perm(WL + (r + 32) * VT_PITCH + (4 * h) * 2), a11 = lds_frag_perm(WL + (r + 32) * VT_PITCH + (16 + 4 * h) * 2);
            o0 = MFMA32(a00, wb0, o0); o0 = MFMA32(a01, wb1, o0); o1 = MFMA32(a10, wb0, o1); o1 = MFMA32(a11, wb1, o1);
        }
        tot += __shfl_xor(tot, 32); R += tot;
        if (__all(R < -153.f)) break;
    }
    float ss = 0.f;
#pragma unroll
    for (int i = 0; i < 16; ++i) ss += o0[i] * o0[i] + o1[i] * o1[i];
    ss += __shfl_xor(ss, 32);
    const float sc = __builtin_amdgcn_rsqf(ss * (1.f / 64.f) + EPS);
    const float* on = P.in[I_SBON] + layer * 256 + hd * 64;
#pragma unroll
    for (int g4 = 0; g4 < 4; ++g4) { const int d0 = 8 * g4 + 4 * h;
        const f32x4 w0 = *(const f32x4*)(on + d0), w1 = *(const f32x4*)(on + 32 + d0);
        u32x2 a, c; a.x = pk2(o0[4 * g4] * sc * w0[0], o0[4 * g4 + 1] * sc * w0[1]); a.y = pk2(o0[4 * g4 + 2] * sc * w0[2], o0[4 * g4 + 3] * sc * w0[3]);
        c.x = pk2(o1[4 * g4] * sc * w1[0], o1[4 * g4 + 1] * sc * w1[1]); c.y = pk2(o1[4 * g4 + 2] * sc * w1[2], o1[4 * g4 + 3] * sc * w1[3]);
        *(u32x2*)(mixrow + hd * 64 + d0) = a; *(u32x2*)(mixrow + hd * 64 + 32 + d0) = c; }
}

constexpr int B_ACUM = 0, B_DTV = 512, B_DTW = 1024, B_BIMG = 2048, B_CIMG = B_BIMG + 32 * 272, B_XT = B_CIMG + 32 * 272, BLOB_BYTES = B_XT + 256 * 80, BLOB_PIECES = BLOB_BYTES / 1024;
static_assert(BLOB_BYTES == 39 * 1024, "blob = 39 DMA pieces");
constexpr int S1_BT = 40960;
constexpr int NCH = 129;
DI unsigned char* ssd_blob(const Params& P, int b, int c, int g) { return P.ws + ((b < 4) ? WS_BLOB1 : WS_BLOB2) + (size_t)(((b & 3) * NCH + (c - 3)) * 2 + g) * BLOB_BYTES; }
#define VMWAIT0() asm volatile("s_waitcnt vmcnt(0)" ::: "memory")
#define LBAR() do { asm volatile("s_waitcnt lgkmcnt(0)" ::: "memory"); __builtin_amdgcn_s_barrier(); asm volatile("" ::: "memory"); } while (0)

constexpr int P_RAW = 51200;
DI void ssd_issue_raw(const bf16* proj, size_t rb, int g, ldsp L  , int w, int lane) {
    const int coloff = lane < 32 ? (C_X + g * 256 + lane * 8) : (lane < 48 ? (C_B + g * 128 + (lane - 32) * 8) : (C_C + g * 128 + (lane - 48) * 8));
#pragma unroll
    for (int q = 0; q < 4; ++q) { const int s = 4 * w + q;
        __builtin_amdgcn_global_load_lds((const unsigned*)(proj + (rb + s) * LDP + coloff), (LAS unsigned*)(L + s * 1024), 16, 0, 0); }
}
DI bf16x8 scale_frag(bf16x8 f, ldsp sc);
DI void ssd_sw1(const Params& P, int layer, ldsp L, int b, int g, int seg) {
    int tid_ = threadIdx.x; asm volatile("" : "+v"(tid_));
    const int tid = tid_, lane = tid & 63, w = __builtin_amdgcn_readfirstlane(tid >> 6);
    const int r = lane & 31, h = lane >> 5, hl = w >> 1, pt = w & 1;
    const bf16* proj = (const bf16*)(P.ws + WS_PROJ);
    const int c_begin = (seg == 0) ? 3 : 4 + 16 * seg, c_end = 20 + 16 * seg;
    unsigned short dtraw = 0, dtnext = 0;
    { const size_t rb0 = rowof(b, 32 * c_begin); ssd_issue_raw(proj, rb0, g, L + P_RAW, w, lane); if (tid < 128) dtraw = proj[(rb0 + (tid & 31)) * LDP + C_DT + 4 * g + ((tid >> 5) & 3)]; }
    int col, ch;
    if (tid < 256) { col = C_X + g * 256 + tid; ch = g * 256 + tid; } else if (tid < 384) { col = C_B + g * 128 + (tid - 256); ch = 512 + g * 128 + (tid - 256); } else { col = C_C + g * 128 + (tid - 384); ch = 768 + g * 128 + (tid - 384); }
    const float* cw = P.in[I_CONVW] + (size_t)layer * 4 * 1024;
    const float cw0 = cw[ch], cw1 = cw[1024 + ch], cw2 = cw[2048 + ch], cw3 = cw[3072 + ch], cb = P.in[I_CONVB][layer * 1024 + ch];
    float um3 = 0.f, um2 = 0.f, um1 = 0.f;
    if (seg > 0) { const size_t r3 = rowof(b, 32 * c_begin - 3); um3 = bf2f(proj[r3 * LDP + col]); um2 = bf2f(proj[(r3 + 1) * LDP + col]); um1 = bf2f(proj[(r3 + 2) * LDP + col]); }
    const int hl2 = (tid >> 5) & 3, s2 = tid & 31, head2 = 4 * g + hl2;
    const float dtb = P.in[I_DTB][layer * 8 + head2], aneg = -fexp(P.in[I_ALOG][layer * 8 + head2]);
    f32x16 st[4]; st[0] = zero16(); st[1] = zero16(); st[2] = zero16(); st[3] = zero16();
    float* Eb = (float*)(P.ws + WS_SSDE); float* Db = (float*)(P.ws + WS_SEGD);
    const int ub = ((b * 2 + g) * NSEG) * 8 + w;
    float logD = 0.f;
    VMWAIT0(); __syncthreads();
    const int xrow = (hl * 64 + 32 * pt + r) * 80;
    for (int c = c_begin; c < c_end; ++c) {
        const int t0 = 32 * c;
        const ldsp RW = L + P_RAW + (((c - c_begin) & 1) ? 32768 : 0);
        if (c + 1 < c_end) { const size_t rbn = rowof(b, t0 + 32); ssd_issue_raw(proj, rbn, g, L + P_RAW + (((c - c_begin) & 1) ? 0 : 32768), w, lane); if (tid < 128) dtnext = proj[(rbn + s2) * LDP + C_DT + head2]; }
        if (tid < 128) {
            const float dr = bf2f(dtraw) + dtb;
            const float dt = (t0 + s2 >= NPAD) ? (fmaxf(dr, 0.f) + log1pf(fexp(-fabsf(dr)))) : 0.f;
            float x = dt * aneg;
#pragma unroll
            for (int off = 1; off < 32; off <<= 1) { const float y = __builtin_bit_cast(float, __builtin_amdgcn_ds_bpermute(((s2 >= off) ? (lane - off) : lane) << 2, __builtin_bit_cast(int, x))); if (s2 >= off) x += y; }
            const float a31 = __builtin_bit_cast(float, __builtin_amdgcn_ds_bpermute((lane | 31) << 2, __builtin_bit_cast(int, x)));
            *(LAS float*)(L + B_ACUM + (hl2 * 32 + s2) * 4) = x; *(LAS float*)(L + B_DTV + (hl2 * 32 + s2) * 4) = dt; *(LAS float*)(L + B_DTW + (hl2 * 32 + s2) * 4) = dt * fexp(a31 - x);
        }
        {
            unsigned pb[16];
#pragma unroll
            for (int s = 0; s < 32; s += 2) { float a[2];
#pragma unroll
                for (int q = 0; q < 2; ++q) { const float u = (t0 + s + q >= NPAD) ? bf2f(*(const LAS unsigned short*)(RW + (s + q) * 1024 + tid * 2)) : 0.f;
                    const float cv = cb + cw0 * um3 + cw1 * um2 + cw2 * um1 + cw3 * u; um3 = um2; um2 = um1; um1 = u; a[q] = cv * __builtin_amdgcn_rcpf(1.f + fexp(-cv)); }
                const unsigned pp = pk2(a[0], a[1]); pb[s >> 1] = pp;
                if (tid >= 256) { const int img = (tid < 384) ? B_BIMG : B_CIMG; const int n = (tid < 384) ? (tid - 256) : (tid - 384);
                    *(LAS unsigned short*)(L + img + s * 272 + n * 2) = (unsigned short)(pp & 0xffffu); *(LAS unsigned short*)(L + img + (s + 1) * 272 + n * 2) = (unsigned short)(pp >> 16); } }
            if (tid < 384) { const int base = (tid < 256) ? (B_XT + tid * 80) : (S1_BT + (tid - 256) * 80);
#pragma unroll
                for (int q = 0; q < 4; ++q) *(LAS u32x4*)(L + base + q * 16) = (u32x4){pb[4 * q], pb[4 * q + 1], pb[4 * q + 2], pb[4 * q + 3]}; }
        }
        LBAR();
        VMWAIT0();
        {
            u32x4* gb = (u32x4*)ssd_blob(P, b, c, g);
            for (int i = tid; i < BLOB_BYTES / 16; i += 512) gb[i] = *(const LAS u32x4*)(L + i * 16);
        }
        {
            const float a31_ = *(const LAS float*)(L + B_ACUM + (hl * 32 + 31) * 4); logD += a31_;
            const float dec = fexp(a31_);
            const bf16x8 xw0 = scale_frag(lds_frag16(L + B_XT + xrow + (8 * h) * 2), L + B_DTW + (hl * 32 + 8 * h) * 4);
            const bf16x8 xw1 = scale_frag(lds_frag16(L + B_XT + xrow + (16 + 8 * h) * 2), L + B_DTW + (hl * 32 + 16 + 8 * h) * 4);
#pragma unroll
            for (int nt = 0; nt < 4; ++nt) {
#pragma unroll
                for (int i = 0; i < 16; ++i) st[nt][i] *= dec;
                st[nt] = MFMA32(lds_frag16(L + S1_BT + (32 * nt + r) * 80 + (8 * h) * 2), xw0, st[nt]);
                st[nt] = MFMA32(lds_frag16(L + S1_BT + (32 * nt + r) * 80 + (16 + 8 * h) * 2), xw1, st[nt]); }
        }
        LBAR();
        dtraw = dtnext;
    }
    {
        float* e = Eb + (size_t)(ub + 8 * seg) * 4096 + lane;
#pragma unroll
        for (int nt = 0; nt < 4; ++nt)
#pragma unroll
            for (int ii = 0; ii < 16; ++ii) e[(nt * 16 + ii) * 64] = st[nt][ii];
        if (lane == 0) Db[ub + 8 * seg] = fexp(logD);
    }
}

constexpr int W_SSQ = 3 * BLOB_BYTES, W_END = W_SSQ + 1024;
static_assert(W_END <= LDS_BAR, "ssd sweep lds");
DI void ssd_issue_blob(const unsigned char* gb, ldsp dst, int w, int lane) {
    for (int pc = w; pc < BLOB_PIECES; pc += 8) __builtin_amdgcn_global_load_lds((const unsigned*)(gb + pc * 1024 + lane * 16), (LAS unsigned*)(dst + pc * 1024), 16, 0, 0);
}
DI bf16x8 scale_frag(bf16x8 f, ldsp sc) {
    const u32x4 u = __builtin_bit_cast(u32x4, f); const f32x4 s0 = *(const LAS f32x4*)sc, s1 = *(const LAS f32x4*)(sc + 16);
    u32x4 o; o[0] = pk2(bflo(u[0]) * s0[0], bfhi(u[0]) * s0[1]); o[1] = pk2(bflo(u[1]) * s0[2], bfhi(u[1]) * s0[3]); o[2] = pk2(bflo(u[2]) * s1[0], bfhi(u[2]) * s1[1]); o[3] = pk2(bflo(u[3]) * s1[2], bfhi(u[3]) * s1[3]);
    return __builtin_bit_cast(bf16x8, o);
}
template <int MODE  >
DI void ssd_unit(const Params& P, int layer, ldsp L, int b, int g, int seg) {
    int tid_ = threadIdx.x; asm volatile("" : "+v"(tid_));
    const int tid = tid_, lane = tid & 63, w = __builtin_amdgcn_readfirstlane(tid >> 6);
    const int r = lane & 31, h = lane >> 5, hl = w >> 1, pt = w & 1, head = 4 * g + hl;
    const bf16* proj = (const bf16*)(P.ws + WS_PROJ); bf16* mix = (bf16*)(P.ws + WS_MIX);
    const float dsk = P.in[I_D][layer * 8 + head];
    const float* nw = P.in[I_SSDNW] + layer * 512 + g * 256 + hl * 64 + 32 * pt;
    f32x4 wnr[4];
#pragma unroll
    for (int g4 = 0; g4 < 4; ++g4) wnr[g4] = *(const f32x4*)(nw + 8 * g4 + 4 * h);
    f32x16 st[4]; st[0] = zero16(); st[1] = zero16(); st[2] = zero16(); st[3] = zero16();
    const int c_begin = (seg == 0) ? 3 : 4 + 16 * seg, c_end = 20 + 16 * seg;
    float* Eb = (float*)(P.ws + WS_SSDE); float* Db = (float*)(P.ws + WS_SEGD);
    const int ub = ((b * 2 + g) * NSEG) * 8 + w;
    ssd_issue_blob(ssd_blob(P, b, c_begin, g), L, w, lane);
    if (c_begin + 1 < c_end) ssd_issue_blob(ssd_blob(P, b, c_begin + 1, g), L + BLOB_BYTES, w, lane);
    if (MODE == 1) {
        for (int i = 0; i < seg; ++i) { const float d = Db[ub + 8 * i]; const float* e = Eb + (size_t)(ub + 8 * i) * 4096 + lane;
#pragma unroll
            for (int nt = 0; nt < 4; ++nt)
#pragma unroll
                for (int ii = 0; ii < 16; ++ii) st[nt][ii] = st[nt][ii] * d + e[(nt * 16 + ii) * 64]; }
    }
    VMWAIT0(); __syncthreads();
    float logD = 0.f;
    const int xrow = (hl * 64 + 32 * pt + r) * 80;
    u32x2 pend[4]; bf16* pend_row = nullptr;
    int slot = 0;
    for (int c = c_begin; c < c_end; ++c) {
        const ldsp I = L + slot * BLOB_BYTES;
        const size_t rowbase = rowof(b, 32 * c);
        u32x2 zr[4];
        if (MODE == 1) {
#pragma unroll
            for (int g4 = 0; g4 < 4; ++g4) zr[g4] = *(const u32x2*)(proj + (rowbase + r) * LDP + C_Z + head * 64 + 32 * pt + 8 * g4 + 4 * h); }
        if (MODE == 1 && pend_row) {
#pragma unroll
            for (int g4 = 0; g4 < 4; ++g4) *(u32x2*)(pend_row + 8 * g4 + 4 * h) = pend[g4]; }
        if (c + 2 < c_end) { const int s2_ = slot + 2 >= 3 ? slot - 1 : slot + 2; ssd_issue_blob(ssd_blob(P, b, c + 2, g), L + s2_ * BLOB_BYTES, w, lane); }
        f32x16 y = zero16(), yo = zero16(); float acum_t = 0.f;
        if (MODE == 1) {
            acum_t = *(const LAS float*)(I + B_ACUM + (hl * 32 + r) * 4);
            f32x16 gt = zero16();
#pragma unroll
            for (int ks = 0; ks < 8; ++ks) gt = MFMA32(lds_frag16(I + B_BIMG + r * 272 + (16 * ks + 8 * h) * 2), lds_frag16(I + B_CIMG + r * 272 + (16 * ks + 8 * h) * 2), gt);
#pragma unroll
            for (int i = 0; i < 16; ++i) { const int s = crow(i, h); const float as = *(const LAS float*)(I + B_ACUM + (hl * 32 + s) * 4), ds = *(const LAS float*)(I + B_DTV + (hl * 32 + s) * 4);
                gt[i] = (s <= r) ? gt[i] * fexp(acum_t - as) * ds : 0.f; }
            y = MFMA32(lds_frag_perm(I + B_XT + xrow + (4 * h) * 2), pack8<0>(gt), y);
            y = MFMA32(lds_frag_perm(I + B_XT + xrow + (16 + 4 * h) * 2), pack8<1>(gt), y);
#pragma unroll
            for (int nt = 0; nt < 4; ++nt) {
                yo = MFMA32(pack8<0>(st[nt]), lds_frag_perm(I + B_CIMG + r * 272 + (32 * nt + 4 * h) * 2), yo);
                yo = MFMA32(pack8<1>(st[nt]), lds_frag_perm(I + B_CIMG + r * 272 + (32 * nt + 16 + 4 * h) * 2), yo); }
        }
        const float eat = fexp(acum_t);
        const float a31_ = *(const LAS float*)(I + B_ACUM + (hl * 32 + 31) * 4); logD += a31_;
        const float dec = fexp(a31_);
        const bf16x8 xw0 = scale_frag(lds_frag16(I + B_XT + xrow + (8 * h) * 2), I + B_DTW + (hl * 32 + 8 * h) * 4);
        const bf16x8 xw1 = scale_frag(lds_frag16(I + B_XT + xrow + (16 + 8 * h) * 2), I + B_DTW + (hl * 32 + 16 + 8 * h) * 4);
#pragma unroll
        for (int nt = 0; nt < 4; ++nt) {
#pragma unroll
            for (int i = 0; i < 16; ++i) st[nt][i] *= dec;
            st[nt] = MFMA32(lds_frag_tr(I + B_BIMG, 272, 8 * h, 32 * nt, lane), xw0, st[nt]);
            st[nt] = MFMA32(lds_frag_tr(I + B_BIMG, 272, 16 + 8 * h, 32 * nt, lane), xw1, st[nt]); }
        if (MODE == 1) {
            float ss = 0.f;
#pragma unroll
            for (int i = 0; i < 16; ++i) { const int pl = 32 * pt + crow(i, h);
                const float xv = bf2f(*(const LAS unsigned short*)(I + B_XT + (hl * 64 + pl) * 80 + r * 2));
                const unsigned zw = zr[i >> 2][(i & 3) >> 1]; const float zv = (i & 1) ? bfhi(zw) : bflo(zw);
                float v = y[i] + eat * yo[i] + xv * dsk; v *= zv * __builtin_amdgcn_rcpf(1.f + fexp(-zv)); y[i] = v; ss += v * v; }
            ss += __shfl_xor(ss, 32);
            if (h == 0) *(LAS float*)(L + W_SSQ + (w * 32 + r) * 4) = ss;
            LBAR();
            float tot = 0.f;
#pragma unroll
            for (int q = 0; q < 8; ++q) tot += *(const LAS float*)(L + W_SSQ + (q * 32 + r) * 4);
            const float sc = __builtin_amdgcn_rsqf(tot * (1.f / 256.f) + EPS);
            pend_row = mix + (rowbase + r) * DM + 256 + head * 64 + 32 * pt;
#pragma unroll
            for (int g4 = 0; g4 < 4; ++g4) { const f32x4 wn = wnr[g4];
                u32x2 o; o.x = pk2(y[4 * g4] * sc * wn[0], y[4 * g4 + 1] * sc * wn[1]); o.y = pk2(y[4 * g4 + 2] * sc * wn[2], y[4 * g4 + 3] * sc * wn[3]);
                pend[g4] = o; }
        }
        if (c + 2 < c_end) { if (w < 7) asm volatile("s_waitcnt vmcnt(5)" ::: "memory"); else asm volatile("s_waitcnt vmcnt(4)" ::: "memory"); }
        else VMWAIT0();
        LBAR();
        slot = slot == 2 ? 0 : slot + 1;
    }
    if (MODE == 1 && pend_row) {
#pragma unroll
        for (int g4 = 0; g4 < 4; ++g4) *(u32x2*)(pend_row + 8 * g4 + 4 * h) = pend[g4]; }
    if (MODE == 0) {
        float* e = Eb + (size_t)(ub + 8 * seg) * 4096 + lane;
#pragma unroll
        for (int nt = 0; nt < 4; ++nt)
#pragma unroll
            for (int ii = 0; ii < 16; ++ii) e[(nt * 16 + ii) * 64] = st[nt][ii];
        if (lane == 0) Db[ub + 8 * seg] = fexp(logD);
    }
    __syncthreads();
}

constexpr int H_DK = 0, H_SSQ = 1024, H_HT = 2048, H_QIMG = 4096, H_KIMG = H_QIMG + 128 * 144, H_KHT = H_KIMG + 128 * 144, H_VT = H_KHT + 256 * 80, H_RAWF = H_VT + 256 * 80, H_RAWQ = H_RAWF + 16384, H_RAWI = H_RAWQ + 16384, H_RAWG = H_RAWI + 16384, H_END = H_RAWG + 16384;
static_assert(H_END <= LDS_BAR, "hgrn lds");
DI void hg_issue(const bf16* proj, size_t rb, ldsp L, int w, int lane, bool with_g) {
#pragma unroll
    for (int q = 0; q < 2; ++q) { const int s0 = 4 * w + 2 * q; const bf16* src = proj + (rb + s0 + (lane >> 5)) * LDP + (lane & 31) * 8;
        __builtin_amdgcn_global_load_lds((const unsigned*)(src + C_FHG), (LAS unsigned*)(L + H_RAWF + s0 * 512), 16, 0, 0);
        if (with_g) __builtin_amdgcn_global_load_lds((const unsigned*)(src + C_QHG), (LAS unsigned*)(L + H_RAWQ + s0 * 512), 16, 0, 0);
        __builtin_amdgcn_global_load_lds((const unsigned*)(src + C_IHG), (LAS unsigned*)(L + H_RAWI + s0 * 512), 16, 0, 0);
        if (with_g) __builtin_amdgcn_global_load_lds((const unsigned*)(src + C_GHG), (LAS unsigned*)(L + H_RAWG + s0 * 512), 16, 0, 0); }
}

template <int MODE>
DI void hgrn_unit(const Params& P, int layer, ldsp L, int b, int seg) {
    int tid_ = threadIdx.x; asm volatile("" : "+v"(tid_));
    const int tid = tid_, lane = tid & 63, w = __builtin_amdgcn_readfirstlane(tid >> 6);
    const int r = lane & 31, h = lane >> 5, hl = w >> 1, pt = w & 1;
    const bf16* proj = (const bf16*)(P.ws + WS_PROJ); bf16* mix = (bf16*)(P.ws + WS_MIX);
    const int j = tid & 255;
    hg_issue(proj, rowof(b, 32 * ((seg == 0) ? 3 : 4 + 8 * seg)), L, w, lane, MODE == 1);
    float lb = 0.f;
    if (layer == 1) { const float l0 = P.in[I_LBL][j], l1 = P.in[I_LBL][256 + j]; lb = 1.f / (1.f + fexp(l1 - l0)); }
    const float oml = 1.f - lb;
    const float* onw = P.in[I_HGON] + layer * 256 + hl * 64 + 32 * pt;
    f32x16 st[2]; st[0] = zero16(); st[1] = zero16();
    f32x16 dacc[2];
#pragma unroll
    for (int i = 0; i < 16; ++i) { dacc[0][i] = 1.f; dacc[1][i] = 1.f; }
    const int c_begin = (seg == 0) ? 3 : 4 + 8 * seg, c_end = 12 + 8 * seg;
    float* Eb = (float*)(P.ws + WS_HGE); float* Db = (float*)(P.ws + WS_HGD);
    const int ub = (b * NSEG_HG) * 8 + w;
    if (MODE == 1) {
        for (int i = 0; i < seg; ++i) { const float* e = Eb + (size_t)(ub + 8 * i) * 2048 + lane; const float* d = Db + (size_t)(ub + 8 * i) * 2048 + lane;
#pragma unroll
            for (int nt = 0; nt < 2; ++nt)
#pragma unroll
                for (int ii = 0; ii < 16; ++ii) st[nt][ii] = st[nt][ii] * d[(nt * 16 + ii) * 64] + e[(nt * 16 + ii) * 64]; }
    }
    VMWAIT0(); __syncthreads();
    const int hf = tid >> 8, hlx = j >> 6, k = j & 63;
    for (int c = c_begin; c < c_end; ++c) {
        const int t0 = 32 * c; const size_t rowbase = rowof(b, t0);
        u32x2 gr[4];
        if (MODE == 1) {
#pragma unroll
            for (int g4 = 0; g4 < 4; ++g4) gr[g4] = *(const LAS u32x2*)(L + H_RAWG + r * 512 + (hl * 64 + 32 * pt + 8 * g4 + 4 * h) * 2); }
        float bc[16], kk[16]; float run = 0.f;
#pragma unroll
        for (int s8 = 0; s8 < 16; ++s8) { const int s = 16 * hf + s8; const bool valid = (t0 + s >= NPAD); const float fl = bf2f(*(const LAS unsigned short*)(L + H_RAWF + s * 512 + j * 2));
            const float e = fexp(-fl); const float sg = __builtin_amdgcn_rcpf(1.f + e);
            const float f = lb + oml * sg; const float lf = valid ? flog(fmaxf(f, 1e-30f)) : 0.f;
            run += lf; bc[s8] = run; kk[s8] = valid ? oml * (1.f - sg) : 0.f; }
        *(LAS float*)(L + H_HT + (hf * 256 + j) * 4) = run;
        __syncthreads();
        {
            const float tot0 = *(const LAS float*)(L + H_HT + j * 4), tot1 = *(const LAS float*)(L + H_HT + (256 + j) * 4);
            const float boff = hf ? tot0 : 0.f, b31 = tot0 + tot1;
            unsigned ph[8], pv[8];
#pragma unroll
            for (int s8 = 0; s8 < 16; s8 += 2) { float kh[2];
#pragma unroll
                for (int q = 0; q < 2; ++q) { const int s = 16 * hf + s8 + q; const float bcs = bc[s8 + q] + boff;
                    if (MODE == 1) {
                        const float qv = bf2f(*(const LAS unsigned short*)(L + H_RAWQ + s * 512 + j * 2)); const float qs = qv * __builtin_amdgcn_rcpf(1.f + fexp(-qv));
                        const float eb = fexp(bcs);
                        *(LAS unsigned short*)(L + H_QIMG + (hlx * 32 + s) * 144 + k * 2) = f2bf1(qs * eb);
                        *(LAS unsigned short*)(L + H_KIMG + (hlx * 32 + s) * 144 + k * 2) = f2bf1(kk[s8 + q] * fexp(fminf(-bcs, 80.f))); }
                    kh[q] = kk[s8 + q] * fexp(b31 - bcs); }
                ph[s8 >> 1] = pk2(kh[0], kh[1]);
                const int s = 16 * hf + s8;
                const unsigned lo = (t0 + s >= NPAD) ? (unsigned)*(const LAS unsigned short*)(L + H_RAWI + s * 512 + j * 2) : 0u;
                const unsigned hi = (t0 + s + 1 >= NPAD) ? (unsigned)*(const LAS unsigned short*)(L + H_RAWI + (s + 1) * 512 + j * 2) : 0u;
                pv[s8 >> 1] = lo | (hi << 16); }
#pragma unroll
            for (int q = 0; q < 2; ++q) { *(LAS u32x4*)(L + H_KHT + j * 80 + hf * 32 + q * 16) = (u32x4){ph[4 * q], ph[4 * q + 1], ph[4 * q + 2], ph[4 * q + 3]};
                *(LAS u32x4*)(L + H_VT + j * 80 + hf * 32 + q * 16) = (u32x4){pv[4 * q], pv[4 * q + 1], pv[4 * q + 2], pv[4 * q + 3]}; }
            if (hf == 0) *(LAS float*)(L + H_DK + j * 4) = fexp(b31);
        }
        __syncthreads();
        if (c + 1 < c_end) hg_issue(proj, rowof(b, t0 + 32), L, w, lane, MODE == 1);
        const int vrow = (hl * 64 + 32 * pt + r) * 80;
        f32x16 y = zero16();
        if (MODE == 1) {
        f32x16 gt = zero16();
#pragma unroll
        for (int ks = 0; ks < 4; ++ks) gt = MFMA32(lds_frag16(L + H_KIMG + (hl * 32 + r) * 144 + (16 * ks + 8 * h) * 2), lds_frag16(L + H_QIMG + (hl * 32 + r) * 144 + (16 * ks + 8 * h) * 2), gt);
#pragma unroll
        for (int i = 0; i < 16; ++i) gt[i] = (crow(i, h) <= r) ? gt[i] : 0.f;
        y = MFMA32(lds_frag_perm(L + H_VT + vrow + (4 * h) * 2), pack8<0>(gt), y);
        y = MFMA32(lds_frag_perm(L + H_VT + vrow + (16 + 4 * h) * 2), pack8<1>(gt), y);
#pragma unroll
        for (int nt = 0; nt < 2; ++nt) {
            y = MFMA32(pack8<0>(st[nt]), lds_frag_perm(L + H_QIMG + (hl * 32 + r) * 144 + (32 * nt + 4 * h) * 2), y);
            y = MFMA32(pack8<1>(st[nt]), lds_frag_perm(L + H_QIMG + (hl * 32 + r) * 144 + (32 * nt + 16 + 4 * h) * 2), y); }
        }
#pragma unroll
        for (int nt = 0; nt < 2; ++nt) {
#pragma unroll
            for (int i = 0; i < 16; ++i) { const float dk_ = *(const LAS float*)(L + H_DK + (hl * 64 + 32 * nt + crow(i, h)) * 4); st[nt][i] *= dk_; if (MODE == 0) dacc[nt][i] *= dk_; }
            st[nt] = MFMA32(lds_frag16(L + H_KHT + (hl * 64 + 32 * nt + r) * 80 + (8 * h) * 2), lds_frag16(L + H_VT + vrow + (8 * h) * 2), st[nt]);
            st[nt] = MFMA32(lds_frag16(L + H_KHT + (hl * 64 + 32 * nt + r) * 80 + (16 + 8 * h) * 2), lds_frag16(L + H_VT + vrow + (16 + 8 * h) * 2), st[nt]); }
        if (MODE == 1) {
        float ss = 0.f;
#pragma unroll
        for (int i = 0; i < 16; ++i) ss += y[i] * y[i];
        ss += __shfl_xor(ss, 32);
        if (h == 0) *(LAS float*)(L + H_SSQ + (w * 32 + r) * 4) = ss;
        }
        VMWAIT0(); __syncthreads();
        if (MODE == 1) {
        const float tot = *(const LAS float*)(L + H_SSQ + ((2 * hl) * 32 + r) * 4) + *(const LAS float*)(L + H_SSQ + ((2 * hl + 1) * 32 + r) * 4);
        const float sc = __builtin_amdgcn_rsqf(tot * (1.f / 64.f) + EPS);
        bf16* mrow = mix + (rowbase + r) * DM + 768 + hl * 64 + 32 * pt;
#pragma unroll
        for (int g4 = 0; g4 < 4; ++g4) { const int p0 = 8 * g4 + 4 * h; const f32x4 wn = *(const f32x4*)(onw + p0);
            float o[4];
#pragma unroll
            for (int e = 0; e < 4; ++e) { const unsigned gw_ = gr[g4][e >> 1]; const float gv = (e & 1) ? bfhi(gw_) : bflo(gw_); o[e] = y[4 * g4 + e] * sc * wn[e] * (gv * __builtin_amdgcn_rcpf(1.f + fexp(-gv))); }
            u32x2 ov; ov.x = pk2(o[0], o[1]); ov.y = pk2(o[2], o[3]);
            *(u32x2*)(mrow + p0) = ov; }
        }
    }
    if (MODE == 0) {
        float* e = Eb + (size_t)(ub + 8 * seg) * 2048 + lane; float* d = Db + (size_t)(ub + 8 * seg) * 2048 + lane;
#pragma unroll
        for (int nt = 0; nt < 2; ++nt)
#pragma unroll
            for (int ii = 0; ii < 16; ++ii) { e[(nt * 16 + ii) * 64] = st[nt][ii]; d[(nt * 16 + ii) * 64] = dacc[nt][ii]; }
    }
}

constexpr unsigned SB_SPLIT = 4100u;
DI void sb_dynamic(const Params& P, int layer, ldsp L, int qi, unsigned u0, unsigned u1) {
    int t = threadIdx.x; asm volatile("" : "+v"(t)); const int lane = t & 63, wave = __builtin_amdgcn_readfirstlane(t >> 6);
    unsigned* ctr = (unsigned*)(P.ws + WS_CTL) + 64 * qi;
    for (;;) {
        unsigned u = 0u; if (lane == 0) u = atomicAdd(ctr, 1u);
        u = (unsigned)__builtin_amdgcn_readfirstlane((int)u) + u0;
        if (u >= u1) break;
        if (u < 4096u) { const int bh = (int)(u >> 7), qb = 131 - (int)(u & 127u); sb_unit(P, layer, L + wave * 8192, bh >> 2, bh & 3, qb, lane); }
        else sb_unit(P, layer, L + wave * 8192, 0, (int)(u - 4096u), 3, lane);
    }
}
constexpr int CW_FLAG = 8192;
DI void wg_signal(unsigned* flag) {
    asm volatile("s_waitcnt vmcnt(0)" ::: "memory"); __syncthreads();
    if (threadIdx.x == 0) { __builtin_amdgcn_fence(__ATOMIC_RELEASE, "agent"); asm volatile("s_waitcnt vmcnt(0)" ::: "memory"); (void)__hip_atomic_fetch_add(flag, 1u, __ATOMIC_RELAXED, __HIP_MEMORY_SCOPE_AGENT); }
}
DI void wg_wait(unsigned* flag, unsigned want) {
    if (threadIdx.x == 0) { unsigned sp = 0;
        while (__hip_atomic_load(flag, __ATOMIC_RELAXED, __HIP_MEMORY_SCOPE_AGENT) < want) { __builtin_amdgcn_s_sleep(2); if (++sp > (1u << 22)) break; }
        __builtin_amdgcn_fence(__ATOMIC_ACQUIRE, "agent"); asm volatile("s_waitcnt vmcnt(0)" ::: "memory"); }
    __syncthreads();
}
DI int bxo_() { int b = blockIdx.x; asm volatile("" : "+s"(b)); return b; }
DI void zero_rows(float* p) { int t = threadIdx.x; asm volatile("" : "+v"(t)); int nt = gridDim.x * 512; asm volatile("" : "+s"(nt)); for (int i = bxo_() * 512 + t; i < MROWS; i += nt) p[i] = 0.f; }
DI int bxo() { int b = blockIdx.x; asm volatile("" : "+s"(b)); return b; }
__global__ void __launch_bounds__(512, 2) mega_fwd(Params P) {
    extern __shared__ __attribute__((aligned(16))) unsigned char lds_raw[];
    cg::grid_group grid = cg::this_grid();
    ldsp L = (ldsp)lds_raw;
    const int G = gridDim.x;
    unsigned char* ws = P.ws;
    float* hlead = (float*)(ws + WS_HLEAD); float* ssqA = (float*)(ws + WS_SSQA); float* ssqB = (float*)(ws + WS_SSQB);
    bf16* hb = (bf16*)(ws + WS_HB); bf16* proj = (bf16*)(ws + WS_PROJ); bf16* mix = (bf16*)(ws + WS_MIX); bf16* hid = (bf16*)(ws + WS_HID);

    if (threadIdx.x < 2) *(LAS unsigned*)(L + LDS_BAR + 4 * threadIdx.x) = 0u;
    __syncthreads();
    (void)xcd_barrier_post((unsigned*)(P.ws + WS_CTL) + CW_BAR, (volatile LAS unsigned*)(L + LDS_BAR));
    if (P.ws == nullptr) grid.sync();
    { int t = threadIdx.x; asm volatile("" : "+v"(t)); prologue(P, L, t, t & 63, __builtin_amdgcn_readfirstlane(t >> 6)); }
#define GSYNC() do { XcdBarrier b_; b_.bar = (unsigned*)(P.ws + WS_CTL) + CW_BAR; b_.x = xb_xcc_id(); b_.st = (volatile LAS unsigned*)(L + LDS_BAR); xcd_barrier(b_); } while (0)
    GSYNC();
    for (int l = 0; l < 2; ++l) {
        unsigned char* wb = ws + WS_W + (size_t)l * W_LAYER;
        zero_rows(ssqB);
        { int t = threadIdx.x; asm volatile("" : "+v"(t)); if (bxo() == 255) { u32x4* pz = (u32x4*)(proj + (size_t)MMAIN * LDP); const u32x4 z = {0u, 0u, 0u, 0u}; for (int i = t; i < 16 * LDP / 8; i += 512) pz[i] = z; } }
        lead_gemm<0>(L, hb + (size_t)LEADROW * DM, (const bf16*)(wb + W_IN), LDP, DM, proj + (size_t)LEADROW * LDP, LDP, ssqA + LEADROW, nullptr, nullptr);
        { pg8::Gemm g{hb, (const bf16*)(wb + W_IN), MMAIN, LDP, DM}; pg8::StaticOrder S; S.init(MMAIN, LDP, G, bxo());
          pg8::EpiScale<0> E{proj, LDP, ssqA};
          pg8::gemm_phase<pg8::EpiScale<0>, pg8::StaticOrder, true, true>(L, g, S, E); }
        GSYNC();
        zero_rows(ssqA);
        { const int bx = bxo();
          unsigned* flg = (unsigned*)(P.ws + WS_CTL) + CW_FLAG + 64 * (32 * l);
          if (bx < 128) { const int bg = bx >> 3, sg = bx & 7;
              ssd_sw1(P, l, L, bg >> 1, bg & 1, sg); wg_signal(flg + 64 * bg); wg_wait(flg + 64 * bg, 8u);
              ssd_unit<1>(P, l, L, bg >> 1, bg & 1, sg); }
          else { const int q = bx - 128, hb_ = q >> 4, sg = q & 15;
              if (sg < 15) { hgrn_unit<0>(P, l, L, hb_, sg); wg_signal(flg + 64 * (16 + hb_)); }
              wg_wait(flg + 64 * (16 + hb_), 15u);
              hgrn_unit<1>(P, l, L, hb_, sg); }
          __syncthreads();
          sb_dynamic(P, l, L, 4 + 2 * l, 0u, 4100u);
          if (l == 0) convert_dynamic(P, L); }
        GSYNC();
        lead_gemm<2>(L, mix + (size_t)LEADROW * DM, (const bf16*)(wb + W_OUT), DM, DM, hb + (size_t)LEADROW * DM, DM, nullptr, hlead, ssqB + LEADROW);
        { pg8::Gemm g{mix, (const bf16*)(wb + W_OUT), MMAIN, DM, DM}; pg8::StaticOrder S; S.init(MMAIN, DM, G, bxo());
          pg8::EpiResid E{(l == 0) ? P.in[I_X] : (const float*)P.out, P.out, hb, ssqB};
          pg8::gemm_phase<pg8::EpiResid, pg8::StaticOrder, true, true>(L, g, S, E); }
        GSYNC();
        lead_gemm<1>(L, hb + (size_t)LEADROW * DM, (const bf16*)(wb + W_UP), DFF, DM, hid + (size_t)LEADROW * DFF, DFF, ssqB + LEADROW, nullptr, nullptr);
        { pg8::Gemm g{hb, (const bf16*)(wb + W_UP), MMAIN, DFF, DM}; pg8::StaticOrder S; S.init(MMAIN, DFF, G, bxo());
          pg8::EpiScale<1> E{hid, DFF, ssqB};
          pg8::gemm_phase<pg8::EpiScale<1>, pg8::StaticOrder, true, true>(L, g, S, E); }
        GSYNC();
        lead_gemm<2>(L, hid + (size_t)LEADROW * DFF, (const bf16*)(wb + W_DOWN), DM, DFF, hb + (size_t)LEADROW * DM, DM, nullptr, hlead, ssqA + LEADROW);
        { pg8::Gemm g{hid, (const bf16*)(wb + W_DOWN), MMAIN, DM, DFF}; pg8::StaticOrder S; S.init(MMAIN, DM, G, bxo());
          pg8::EpiResid E{(const float*)P.out, P.out, hb, ssqA};
          pg8::gemm_phase<pg8::EpiResid, pg8::StaticOrder, true, true>(L, g, S, E); }
        if (l == 0) GSYNC();
    }
}

extern "C" void kernel_launch(void* const* d_in, const int* in_sizes, int n_in, void* d_out, int out_size, void* d_ws, size_t ws_size, hipStream_t stream) {
    static int grid = 0;
    if (grid == 0) {
        if (n_in != 19 || out_size != NB * SEQ * DM || ws_size < WS_END) { fprintf(stderr, "kernel_launch: unexpected shapes (n_in %d out %d ws %zu)\n", n_in, out_size, ws_size); grid = -1; return; }
        int dev = 0, cus = 0, per_cu = 0;
        hipGetDevice(&dev); hipDeviceGetAttribute(&cus, hipDeviceAttributeMultiprocessorCount, dev);
        hipFuncSetAttribute((const void*)mega_fwd, hipFuncAttributeMaxDynamicSharedMemorySize, LDS_BYTES);
        hipOccupancyMaxActiveBlocksPerMultiprocessor(&per_cu, (const void*)mega_fwd, 512, LDS_BYTES);
        (void)hipGetLastError();
        if (per_cu < 1) per_cu = 1;
        grid = cus;
        if (grid > 256) grid = 256;
    }
    if (grid < 0) return;
    Params p{};
    for (int i = 0; i < 19; ++i) p.in[i] = (const float*)d_in[i];
    p.out = (float*)d_out; p.ws = (unsigned char*)d_ws;
    (void)hipMemsetAsync(d_ws, 0, 65536, stream);
    void* args[] = {&p};
    hipError_t e = hipLaunchCooperativeKernel((const void*)mega_fwd, dim3(grid), dim3(512), args, LDS_BYTES, stream);
    if (e != hipSuccess) fprintf(stderr, "cooperative launch failed: %s (grid %d)\n", hipGetErrorString(e), grid);
}
```

```cpp
#include <hip/hip_runtime.h>
#include <hip/hip_cooperative_groups.h>
#include <cstdio>
#include <cstdint>
namespace cg = cooperative_groups;
namespace pg8 {
#define PG8_LAS __attribute__((address_space(3)))
typedef unsigned short bf16_t;
typedef short bf16x8 __attribute__((ext_vector_type(8)));
typedef float f32x4 __attribute__((ext_vector_type(4)));
typedef unsigned u32x4 __attribute__((ext_vector_type(4)));
constexpr int BM = 256, BK = 64, HALF = 128, HTB = HALF * BK * 2  , STAGE_BYTES = 8 * HTB, NXCD = 8, WGM = 8;

__host__ __device__ __forceinline__ int lds_byte(int r, int c) { const int st = (r >> 4) * 2 + (c >> 5), rr = r & 15, cc = c & 31, ob = rr * 64 + cc * 2; return st * 1024 + (ob ^ (((ob >> 9) & 1) << 5)); }
__host__ __device__ __forceinline__ void stage_rc(int b, int& R, int& C) { const int st = b / 1024, sb = b % 1024, swz = sb ^ (((sb >> 9) & 1) << 5); R = (st >> 1) * 16 + swz / 64; C = (st & 1) * 32 + (swz % 64) / 2; }
__host__ __device__ __forceinline__ int perm32(int rho) { const int n = rho >> 4, i = rho & 15; return 8 * (i >> 2) + 4 * n + (i & 3); }

struct Unit { int pm, pn; };
struct Gemm { const bf16_t* A; const bf16_t* Bt; int M, N, K; };

struct StaticOrder {
    int nM, nN, nwg, G, c;
    __host__ __device__ void init(int M, int N, int G_, int c_) { nM = M / BM; nN = N / BM; nwg = nM * nN; G = G_; c = c_; }
    __host__ __device__ bool next(int i, Unit& u) const {
        const long L = (long)i * G + c; if (L >= nwg) return false;
        int wgid = (int)L; { const int q = nwg / NXCD, r = nwg % NXCD, xcd = wgid % NXCD, off = wgid / NXCD; wgid = (xcd < r ? xcd * (q + 1) : r * (q + 1) + (xcd - r) * q) + off; }
        const int nig = WGM * nN, gid = wgid / nig, fm = gid * WGM, gsz = (nM - fm) < WGM ? (nM - fm) : WGM;
        u.pm = fm + ((wgid % nig) % gsz); u.pn = (wgid % nig) / gsz; return true;
    }
    __device__ __forceinline__ void a_ready(const Unit&) const {}
    __device__ __forceinline__ void done(const Unit&) const {}
};

typedef float f32x2_t __attribute__((ext_vector_type(2))); typedef __bf16 bf16x2_t __attribute__((ext_vector_type(2)));
typedef unsigned u32x2 __attribute__((ext_vector_type(2)));
__device__ __forceinline__ unsigned pk2(float lo, float hi) { f32x2_t v = {lo, hi}; bf16x2_t b = __builtin_convertvector(v, bf16x2_t); return __builtin_bit_cast(unsigned, b); }
constexpr float RMS_EPS = 1e-6f;

template <int ACT> struct EpiScale {
    static constexpr bool PERM = true, AFTER_DRAIN = false;
    bf16_t* O; int ldc; const float* ssq;
    __device__ __forceinline__ void operator()(const f32x4 (&acc)[2][2][4][2], const Unit& u, int wr, int wc, int fr, int fq) const {
        const int row0 = u.pm * BM + wr * 64 + fr; const int col0 = u.pn * BM + wc * 32 + 8 * fq;
        float rsv[2][4];
#pragma unroll
        for (int ai = 0; ai < 2; ++ai)
#pragma unroll
            for (int m = 0; m < 4; ++m) rsv[ai][m] = ssq[row0 + ai * HALF + m * 16];
#pragma unroll
        for (int ai = 0; ai < 2; ++ai)
#pragma unroll
            for (int m = 0; m < 4; ++m) { const int row = row0 + ai * HALF + m * 16;
                const float rs = __builtin_amdgcn_rsqf(rsv[ai][m] * (1.0f / 1024.0f) + RMS_EPS);
                bf16_t* rowp = O + (size_t)row * ldc + col0;
#pragma unroll
                for (int bj = 0; bj < 2; ++bj) { f32x4 v0 = acc[ai][bj][m][0] * rs, v1 = acc[ai][bj][m][1] * rs;
                    if (ACT == 1) {
#pragma unroll
                        for (int e = 0; e < 4; ++e) { float a = fmaxf(v0[e], 0.f), b = fmaxf(v1[e], 0.f); v0[e] = a * a; v1[e] = b * b; } }
                    u32x4 w; w.x = pk2(v0[0], v0[1]); w.y = pk2(v0[2], v0[3]); w.z = pk2(v1[0], v1[1]); w.w = pk2(v1[2], v1[3]);
                    *(u32x4*)(rowp + bj * HALF) = w; }
                if (m & 1) asm volatile("" ::: "memory"); }
    }
};
struct EpiResid {
    static constexpr bool PERM = false, AFTER_DRAIN = false;
    const float* smain; float* dmain; bf16_t* hb; float* ssq;
    __device__ __forceinline__ void operator()(const f32x4 (&acc)[2][2][4][2], const Unit& u, int wr, int wc, int fr, int fq) const {
        const int row0 = u.pm * BM + wr * 64 + fr; const int col0 = u.pn * BM + wc * 32 + 4 * fq;
#pragma unroll
        for (int ai = 0; ai < 2; ++ai)
#pragma unroll
            for (int m = 0; m < 4; ++m) { const int row = row0 + ai * HALF + m * 16;
                const float* sp = smain + (size_t)row * 1024;
                float* dp = dmain + (size_t)row * 1024;
                bf16_t* bp = hb + (size_t)row * 1024; float sq = 0.f;
#pragma unroll
                for (int bj = 0; bj < 2; ++bj)
#pragma unroll
                    for (int n = 0; n < 2; ++n) { const int c = col0 + bj * HALF + n * 16;
                        const f32x4 v = *(const f32x4*)(sp + c) + acc[ai][bj][m][n];
                        *(f32x4*)(dp + c) = v; sq += (v[0] * v[0] + v[1] * v[1]) + (v[2] * v[2] + v[3] * v[3]);
                        u32x2 w; w.x = pk2(v[0], v[1]); w.y = pk2(v[2], v[3]); *(u32x2*)(bp + c) = w; }
                sq += __shfl_xor(sq, 16); sq += __shfl_xor(sq, 32);
                if (fq == 0) atomicAdd(ssq + row, sq);
                if (m == 3) asm volatile("" ::: "memory"); }
    }
};

template <class Epi, class Sched, bool ALIGN_EPI = false, bool SP2 = false>
__device__ __forceinline__ void gemm_phase(PG8_LAS unsigned char* lds, const Gemm g, const Sched& S, const Epi& E) {
    int tid_ = threadIdx.x; asm volatile("" : "+v"(tid_));
    const int tid = tid_, wid = __builtin_amdgcn_readfirstlane(tid >> 6), lane = tid & 63, wr = wid >> 2, wc = wid & 3, fr = lane & 15, fq = lane >> 4;
    const int K = g.K, nt = K / BK;
    unsigned voffA[2], voffB[2];
#pragma unroll
    for (int i = 0; i < 2; ++i) { int R, C; stage_rc(tid * 16 + i * 8192, R, C); const int Rb = Epi::PERM ? ((R & ~31) + perm32(R & 31)) : R;
        voffA[i] = (unsigned)(R * K + C) * 2u; voffB[i] = (unsigned)(Rb * K + C) * 2u; }
    const size_t kstep = (size_t)(BK * 2);
    const size_t hstep = (size_t)HALF * K * 2;
    const size_t tstep = 2 * hstep;
    const unsigned ldsw = (unsigned)wid * 1024u;
    const int aoff = lds_byte(wr * 64 + fr, fq * 8), boff = lds_byte(wc * 32 + fr, fq * 8);
#define PG8_SA(b, h) (((b) * 2 + (h)) * HTB)
#define PG8_SB(b, h) ((4 + (b) * 2 + (h)) * HTB)
#define PG8_STAGE(bufoff, gbase, voff) do { _Pragma("unroll") for (int _i = 0; _i < 2; ++_i) \
        __builtin_amdgcn_global_load_lds((const unsigned*)((const char*)(gbase) + (voff)[_i]), (PG8_LAS unsigned*)(lds + (bufoff) + ldsw + _i * 8192), 16, 0, 0); } while (0)
#define PG8_LDA(dst, b, h) do { _Pragma("unroll") for (int m = 0; m < 4; ++m) _Pragma("unroll") for (int k = 0; k < 2; ++k) dst[m][k] = *(const PG8_LAS bf16x8*)(lds + PG8_SA(b, h) + aoff + m * 2048 + k * 1024); } while (0)
#define PG8_LDB(dst, b, h) do { _Pragma("unroll") for (int n = 0; n < 2; ++n) _Pragma("unroll") for (int k = 0; k < 2; ++k) dst[n][k] = *(const PG8_LAS bf16x8*)(lds + PG8_SB(b, h) + boff + n * 2048 + k * 1024); } while (0)
#define PG8_MMA(ai, bj, At, Bt) do { __builtin_amdgcn_s_setprio(1); _Pragma("unroll") for (int m = 0; m < 4; ++m) _Pragma("unroll") for (int n = 0; n < 2; ++n) _Pragma("unroll") for (int k = 0; k < 2; ++k) \
        acc[ai][bj][m][n] = __builtin_amdgcn_mfma_f32_16x16x32_bf16(Bt[n][k], At[m][k], acc[ai][bj][m][n], 0, 0, 0); __builtin_amdgcn_s_setprio(0); } while (0)
#define PG8_WAIT_V(n) asm volatile("s_waitcnt vmcnt(" #n ")" ::: "memory")
#define PG8_WAIT_L(n) asm volatile("s_waitcnt lgkmcnt(" #n ")" ::: "memory")
#define PG8_BAR __builtin_amdgcn_s_barrier()
#define PG8_SCHED __builtin_amdgcn_sched_barrier(0)
    Unit cur, nxt; int ui = 0;
    if (!S.next(0, cur)) return;
    f32x4 acc[2][2][4][2];
#pragma unroll
    for (int a = 0; a < 2; ++a)
#pragma unroll
        for (int b = 0; b < 2; ++b)
#pragma unroll
            for (int m = 0; m < 4; ++m)
#pragma unroll
                for (int n = 0; n < 2; ++n) acc[a][b][m][n] = (f32x4){0.f, 0.f, 0.f, 0.f};
    bf16x8 At[4][2], B0[2][2], B1[2][2];
    const char* cA = (const char*)g.A + (size_t)cur.pm * tstep; const char* cB = (const char*)g.Bt + (size_t)cur.pn * tstep;
    S.a_ready(cur);
    if constexpr (SP2) {
        PG8_STAGE(PG8_SB(0, 0), cB, voffB); PG8_STAGE(PG8_SB(0, 1), cB + hstep, voffB); PG8_STAGE(PG8_SA(0, 0), cA, voffA); PG8_STAGE(PG8_SA(0, 1), cA + hstep, voffA);
        if (wr == 1) PG8_BAR;
        PG8_WAIT_V(2); PG8_BAR;
        PG8_STAGE(PG8_SB(1, 0), cB + kstep, voffB); PG8_STAGE(PG8_SA(1, 0), cA + kstep, voffA); PG8_STAGE(PG8_SB(1, 1), cB + hstep + kstep, voffB);
        PG8_WAIT_V(6); PG8_BAR;
    } else {
        PG8_STAGE(PG8_SB(0, 0), cB, voffB); PG8_STAGE(PG8_SA(0, 0), cA, voffA); PG8_STAGE(PG8_SB(0, 1), cB + hstep, voffB); PG8_STAGE(PG8_SA(0, 1), cA + hstep, voffA);
        if (wr == 1) PG8_BAR;
        PG8_WAIT_V(4); PG8_BAR;
        PG8_STAGE(PG8_SB(1, 0), cB + kstep, voffB); PG8_STAGE(PG8_SA(1, 0), cA + kstep, voffA); PG8_STAGE(PG8_SB(1, 1), cB + hstep + kstep, voffB);
        PG8_WAIT_V(6); PG8_BAR;
    }
    for (;;) {
        const bool has_next = S.next(ui + 1, nxt);
        const char* nA = has_next ? (const char*)g.A + (size_t)nxt.pm * tstep : cA; const char* nB = has_next ? (const char*)g.Bt + (size_t)nxt.pn * tstep : cB;
        for (int t = 0; t < nt; t += 2) {
            const bool last = (t == nt - 2);
            const char* a1 = cA + (size_t)(t + 1) * kstep;
            const char* a2 = last ? nA : cA + (size_t)(t + 2) * kstep; const char* b2 = last ? nB : cB + (size_t)(t + 2) * kstep;
            const char* a3 = a2 + kstep; const char* b3 = b2 + kstep;
            if (last && has_next) S.a_ready(nxt);
            if constexpr (SP2) {
            PG8_LDB(B0, 0, 0); PG8_LDB(B1, 0, 1); PG8_SCHED; PG8_LDA(At, 0, 0); PG8_STAGE(PG8_SA(1, 1), a1 + hstep, voffA);
            PG8_WAIT_V(8); PG8_WAIT_L(0); PG8_BAR; PG8_MMA(0, 0, At, B0); PG8_MMA(0, 1, At, B1); PG8_BAR; PG8_SCHED;
            PG8_LDA(At, 0, 1); PG8_STAGE(PG8_SB(0, 0), b2, voffB); PG8_STAGE(PG8_SB(0, 1), b2 + hstep, voffB); PG8_STAGE(PG8_SA(0, 0), a2, voffA);
            PG8_WAIT_V(8); PG8_WAIT_L(0); PG8_BAR; PG8_MMA(1, 0, At, B0); PG8_MMA(1, 1, At, B1); PG8_BAR; PG8_SCHED;
            PG8_LDB(B0, 1, 0); PG8_LDB(B1, 1, 1); PG8_SCHED; PG8_LDA(At, 1, 0); PG8_STAGE(PG8_SA(0, 1), a2 + hstep, voffA);
            PG8_WAIT_V(8); PG8_WAIT_L(0); PG8_BAR; PG8_MMA(0, 0, At, B0); PG8_MMA(0, 1, At, B1); PG8_BAR; PG8_SCHED;
            PG8_LDA(At, 1, 1); PG8_STAGE(PG8_SB(1, 0), b3, voffB); PG8_STAGE(PG8_SB(1, 1), b3 + hstep, voffB); PG8_STAGE(PG8_SA(1, 0), a3, voffA);
            PG8_WAIT_V(8); PG8_WAIT_L(0); PG8_BAR; PG8_MMA(1, 0, At, B0); PG8_MMA(1, 1, At, B1); PG8_BAR; PG8_SCHED;
            } else {
            PG8_LDB(B0, 0, 0); PG8_SCHED; PG8_LDA(At, 0, 0); PG8_STAGE(PG8_SA(1, 1), a1 + hstep, voffA);
            PG8_WAIT_L(8); PG8_BAR; PG8_WAIT_L(0); PG8_MMA(0, 0, At, B0); PG8_BAR; PG8_SCHED;
            PG8_LDB(B1, 0, 1); PG8_STAGE(PG8_SB(0, 0), b2, voffB);
            PG8_BAR; PG8_WAIT_L(0); PG8_MMA(0, 1, At, B1); PG8_BAR;
            PG8_LDA(At, 0, 1); PG8_STAGE(PG8_SA(0, 0), a2, voffA);
            PG8_BAR; PG8_WAIT_L(0); PG8_MMA(1, 0, At, B0); PG8_BAR; PG8_SCHED;
            PG8_STAGE(PG8_SB(0, 1), b2 + hstep, voffB);
            PG8_WAIT_V(6); PG8_BAR; PG8_MMA(1, 1, At, B1); PG8_BAR;
            PG8_LDB(B0, 1, 0); PG8_SCHED; PG8_LDA(At, 1, 0); PG8_STAGE(PG8_SA(0, 1), a2 + hstep, voffA);
            PG8_WAIT_L(8); PG8_BAR; PG8_WAIT_L(0); PG8_MMA(0, 0, At, B0); PG8_BAR; PG8_SCHED;
            PG8_LDB(B1, 1, 1); PG8_STAGE(PG8_SB(1, 0), b3, voffB);
            PG8_BAR; PG8_WAIT_L(0); PG8_MMA(0, 1, At, B1); PG8_BAR;
            PG8_LDA(At, 1, 1); PG8_STAGE(PG8_SA(1, 0), a3, voffA);
            PG8_BAR; PG8_WAIT_L(0); PG8_MMA(1, 0, At, B0); PG8_BAR; PG8_SCHED;
            PG8_STAGE(PG8_SB(1, 1), b3 + hstep, voffB);
            PG8_WAIT_V(6); PG8_BAR; PG8_MMA(1, 1, At, B1); PG8_BAR;
            }
        }
        if constexpr (ALIGN_EPI) { if (wr == 0) PG8_BAR; }
        if constexpr (!Epi::AFTER_DRAIN) { E(acc, cur, wr, wc, fr, fq); S.done(cur); }
        if (!has_next) break;
#pragma unroll
        for (int a = 0; a < 2; ++a)
#pragma unroll
            for (int b = 0; b < 2; ++b)
#pragma unroll
                for (int m = 0; m < 4; ++m)
#pragma unroll
                    for (int n = 0; n < 2; ++n) acc[a][b][m][n] = (f32x4){0.f, 0.f, 0.f, 0.f};
        cur = nxt; cA = nA; cB = nB; ++ui;
        if constexpr (ALIGN_EPI) { if (wr == 1) PG8_BAR; }
    }
    PG8_WAIT_V(0);
    if constexpr (!ALIGN_EPI) { if (wr == 0) PG8_BAR; }
    PG8_BAR;
    if constexpr (Epi::AFTER_DRAIN) { E.fused(acc, cur, wr, wc, fr, fq, lds, wid, lane); S.done(cur); }
#undef PG8_SA
#undef PG8_SB
#undef PG8_STAGE
#undef PG8_LDA
#undef PG8_LDB
#undef PG8_MMA
#undef PG8_WAIT_V
#undef PG8_WAIT_L
#undef PG8_BAR
#undef PG8_SCHED
}
}
#define DI __device__ __forceinline__
#define LAS __attribute__((address_space(3)))
typedef LAS unsigned char* ldsp;
typedef unsigned short bf16;
typedef short bf16x8 __attribute__((ext_vector_type(8)));
typedef short s16x4 __attribute__((ext_vector_type(4)));
typedef float f32x16 __attribute__((ext_vector_type(16)));
typedef float f32x4 __attribute__((ext_vector_type(4)));
typedef unsigned u32x4 __attribute__((ext_vector_type(4)));
typedef unsigned u32x2 __attribute__((ext_vector_type(2)));
using pg8::pk2;

constexpr int NB = 8, SEQ = 4096, DM = 1024, DFF = 4096, MMAIN = NB * SEQ, MROWS = MMAIN + 32, LEADROW = MMAIN + 16;
constexpr int LDP = 3584;
constexpr int DIN = 3336;
constexpr int NPAD = 112;
constexpr int C_QSB = 0, C_KSB = 256, C_VSB = 512, C_Z = 768, C_X = 1280, C_B = 1792, C_C = 2048, C_QHG = 2304, C_FHG = 2560, C_IHG = 2816, C_GHG = 3072, C_DT = 3328;
constexpr float EPS = 1e-6f;

constexpr size_t MiB = 1u << 20;
constexpr size_t WS_W = 2 * MiB, W_LAYER = 25 * MiB, W_IN = 0, W_OUT = 7 * MiB, W_UP = 9 * MiB, W_DOWN = 17 * MiB;
constexpr size_t WS_HLEAD = 52 * MiB, WS_SSQA = 56 * MiB, WS_SSQB = 57 * MiB, WS_HB = 58 * MiB, WS_PROJ = 124 * MiB, WS_MIX = 355 * MiB, WS_HID = 124 * MiB, WS_SSDE = 421 * MiB, WS_HGE = 437 * MiB, WS_HGD = 445 * MiB, WS_SEGD = 453 * MiB, WS_BLOB2 = 454 * MiB, WS_BLOB1 = WS_HB  , WS_CTL = 0, WS_END = 504 * MiB;
constexpr int NSEG = 8, NSEG_HG = 16;
constexpr int LDS_BYTES = 147456 + 64;
constexpr int LDS_BAR = 147456;
constexpr int CW_BAR = 4096;

struct Params { const float* in[19]; float* out; unsigned char* ws; };
enum { I_X = 0, I_META, I_LBL, I_NMIX, I_WIN, I_QN, I_KN, I_SBON, I_CONVW, I_CONVB, I_DTB, I_ALOG, I_D, I_SSDNW, I_HGON, I_WOUT, I_NMLP, I_WUP, I_WDOWN };

DI float bflo(unsigned w) { return __uint_as_float(w << 16); }
DI float bfhi(unsigned w) { return __uint_as_float(w & 0xffff0000u); }
DI float bf2f(unsigned short b) { return __uint_as_float(((unsigned)b) << 16); }
DI unsigned short f2bf1(float f) { return (unsigned short)(pk2(f, 0.f) & 0xffffu); }
DI float fexp(float x) { return __builtin_amdgcn_exp2f(x * 1.4426950408889634f); }
DI float flog(float x) { return __builtin_amdgcn_logf(x) * 0.6931471805599453f; }
DI int crow(int i, int h) { return (i & 3) + 8 * (i >> 2) + 4 * h; }
DI size_t rowof(int b, int t) { return t < 128 ? (size_t)(MMAIN + (t - 96)) : (size_t)(b * 4096 + (t - 128)); }
DI float wave_sum(float v) {
#pragma unroll
    for (int o = 1; o < 64; o <<= 1) v += __shfl_xor(v, o);
    return v;
}
#define MFMA32(a, b, c) __builtin_amdgcn_mfma_f32_32x32x16_bf16((a), (b), (c), 0, 0, 0)
template <int S> DI bf16x8 pack8(const f32x16& x) {
    u32x4 p; p[0] = pk2(x[8 * S + 0], x[8 * S + 1]); p[1] = pk2(x[8 * S + 2], x[8 * S + 3]); p[2] = pk2(x[8 * S + 4], x[8 * S + 5]); p[3] = pk2(x[8 * S + 6], x[8 * S + 7]);
    return __builtin_bit_cast(bf16x8, p);
}
DI bf16x8 lds_frag16(ldsp p) { return *(const LAS bf16x8*)p; }
DI bf16x8 lds_frag_perm(ldsp p) {
    const s16x4 lo = *(const LAS s16x4*)p; const s16x4 hi = *(const LAS s16x4*)(p + 16);
    return __builtin_shufflevector(lo, hi, 0, 1, 2, 3, 4, 5, 6, 7);
}
typedef short v4i16_t __attribute__((ext_vector_type(4)));
DI bf16x8 lds_frag_tr(ldsp img, int pitch, int k0, int m0, int lane) {
    const int i16 = lane & 15, q = i16 >> 2, p = i16 & 3, blk = (lane >> 4) & 1;
    ldsp a = img + (k0 + q) * pitch + (m0 + 16 * blk + 4 * p) * 2;
    const s16x4 lo = __builtin_bit_cast(s16x4, __builtin_amdgcn_ds_read_tr16_b64_v4i16((LAS v4i16_t*)a));
    const s16x4 hi = __builtin_bit_cast(s16x4, __builtin_amdgcn_ds_read_tr16_b64_v4i16((LAS v4i16_t*)(a + 4 * pitch)));
    return __builtin_shufflevector(lo, hi, 0, 1, 2, 3, 4, 5, 6, 7);
}
DI f32x16 zero16() { f32x16 z;
#pragma unroll
    for (int i = 0; i < 16; ++i) z[i] = 0.f;
    return z; }

#define XB_TMO      128
#define XB_XCNT(j)  (256  + 64 * (j))
#define XB_XSUB(j)  (1280 + 64 * (j))
#define XB_XGEN(j)  (2304 + 64 * (j))
#define XB_TOP      3328
#define XB_TOPGEN   3392
#define XCD_BAR_WORDS 3456
#define XB_SPIN_CAP (1u << 18)

__device__ __forceinline__ unsigned xb_ld(unsigned* p)              { return __hip_atomic_load(p, __ATOMIC_RELAXED, __HIP_MEMORY_SCOPE_AGENT); }
__device__ __forceinline__ unsigned xb_add(unsigned* p, unsigned v) { return __hip_atomic_fetch_add(p, v, __ATOMIC_RELAXED, __HIP_MEMORY_SCOPE_AGENT); }
__device__ __forceinline__ unsigned xb_xcc_id() { return (unsigned)__builtin_amdgcn_s_getreg((3 << 11) | 20) & 0xFu; }
#define XB_SPIN(cond, bar) do { unsigned _sp = 0; while (cond) { __builtin_amdgcn_s_sleep(1); \
    if ((++_sp & 255u) == 0u) { if (xb_ld(&(bar)[XB_TMO])) break; if (_sp > XB_SPIN_CAP) { atomicAdd(&(bar)[XB_TMO], 1u); break; } } } } while (0)

struct XcdBarrier {
    unsigned* bar; unsigned x;
    volatile LAS unsigned* st;
};
__device__ __forceinline__ XcdBarrier xcd_barrier_post(unsigned* bar, volatile LAS unsigned* st) {
    XcdBarrier b; b.bar = bar; b.x = xb_xcc_id(); b.st = st;
    if (threadIdx.x == 0) (void)xb_add(&bar[XB_XCNT(b.x)], 1u);
    return b;
}
__device__ __forceinline__ void xcd_barrier_complete(unsigned* bar, unsigned x, unsigned& nloc, unsigned& nx) {
    const unsigned G = gridDim.x * gridDim.y * gridDim.z;
    unsigned sum, cnt, mine, sp = 0u;
    for (;;) {
        sum = 0u; cnt = 0u; mine = 0u;
#pragma unroll
        for (unsigned j = 0; j < 16; ++j) { const unsigned c = xb_ld(&bar[XB_XCNT(j)]); sum += c; cnt += (c > 0u) ? 1u : 0u; mine = (j == x) ? c : mine; }
        if (sum == G) break;
        __builtin_amdgcn_s_sleep(1);
        if ((++sp & 255u) == 0u) { if (xb_ld(&bar[XB_TMO])) break; if (sp > XB_SPIN_CAP) { atomicAdd(&bar[XB_TMO], 1u); break; } }
    }
    nloc = mine > 0u ? mine : 1u; nx = cnt > 0u ? cnt : 1u;
}

__device__ __forceinline__ void xcd_barrier(const XcdBarrier& b) {
    asm volatile("s_waitcnt vmcnt(0)" ::: "memory");
    __syncthreads();
    if (threadIdx.x == 0) {
        unsigned* bar = b.bar;
        __builtin_amdgcn_s_waitcnt(0);
        unsigned nloc = b.st[0], nx = b.st[1];
        if (nloc == 0u) { xcd_barrier_complete(bar, b.x, nloc, nx); b.st[0] = nloc; b.st[1] = nx; }
        const unsigned old = xb_add(&bar[XB_XSUB(b.x)], 1u);
        const unsigned gen = old / nloc;
        if (old + 1u == (gen + 1u) * nloc) {
            __builtin_amdgcn_fence(__ATOMIC_RELEASE, "agent");
            asm volatile("s_waitcnt vmcnt(0)" ::: "memory");
            const unsigned og = xb_add(&bar[XB_TOP], 1u);
            const unsigned tg = og / nx;
            if (og + 1u == (tg + 1u) * nx) xb_add(&bar[XB_TOPGEN], 1u);
            else XB_SPIN(xb_ld(&bar[XB_TOPGEN]) == tg, bar);
            __builtin_amdgcn_fence(__ATOMIC_ACQUIRE, "agent");
            xb_add(&bar[XB_XGEN(b.x)], 1u);
            asm volatile("s_waitcnt vmcnt(0)" ::: "memory");
        } else {
            XB_SPIN(xb_ld(&bar[XB_XGEN(b.x)]) == gen, bar);
            __builtin_amdgcn_fence(__ATOMIC_ACQUIRE, "agent");
            asm volatile("s_waitcnt vmcnt(0)" ::: "memory");
        }
    }
    __syncthreads();
}

DI void transpose_item(const float* W, int K, int Nsrc, bf16* WT, const float* kscale, int mode, LAS float* scr, int item, int nblk, int lane) {
    const int kb = item / nblk, nb = item % nblk, k0 = 64 * kb, n0 = 32 * nb;
    const int nn = n0 + (lane & 31); int src = nn; bool ok = true;
    if (mode == 1) { if (nn < 2304) src = nn; else if (nn < 3328) src = nn + 8; else if (nn < 3336) src = nn - 3328 + 2304; else { ok = false; src = 0; } }
    float wv[32];
#pragma unroll
    for (int i = 0; i < 32; ++i) { const int kk = 2 * i + (lane >> 5); wv[i] = ok ? W[(size_t)(k0 + kk) * Nsrc + src] : 0.f; }
#pragma unroll
    for (int i = 0; i < 32; ++i) { const int kk = 2 * i + (lane >> 5); float v = wv[i]; if (kscale) v *= kscale[k0 + kk]; scr[kk * 33 + (lane & 31)] = v; }
    asm volatile("s_waitcnt lgkmcnt(0)" ::: "memory");
    const int c = lane & 7;
#pragma unroll
    for (int j = 0; j < 4; ++j) { const int n = (lane >> 3) + 8 * j; const LAS float* s = scr + (8 * c) * 33 + n;
        u32x4 o; o.x = pk2(s[0 * 33], s[1 * 33]); o.y = pk2(s[2 * 33], s[3 * 33]); o.z = pk2(s[4 * 33], s[5 * 33]); o.w = pk2(s[6 * 33], s[7 * 33]);
        *(u32x4*)(WT + (size_t)(n0 + n) * K + k0 + 8 * c) = o; }
    asm volatile("s_waitcnt lgkmcnt(0)" ::: "memory");
}

constexpr int I_IN = 16 * 112, I_OUT = 16 * 32, I_UP = 16 * 128, I_DN = 64 * 32, I_LAYER = I_IN + I_OUT + I_UP + I_DN;
DI void convert_item(const Params& P, LAS float* scr, int it, int lane) {
    const int l = it / I_LAYER; int r = it % I_LAYER;
    unsigned char* wb = P.ws + WS_W + (size_t)l * W_LAYER;
    if (r < I_IN) { transpose_item(P.in[I_WIN] + (size_t)l * DM * DIN, DM, DIN, (bf16*)(wb + W_IN), P.in[I_NMIX] + l * DM, 1, scr, r, 112, lane); return; } r -= I_IN;
    if (r < I_OUT) { transpose_item(P.in[I_WOUT] + (size_t)l * DM * DM, DM, DM, (bf16*)(wb + W_OUT), nullptr, 0, scr, r, 32, lane); return; } r -= I_OUT;
    if (r < I_UP) { transpose_item(P.in[I_WUP] + (size_t)l * DM * DFF, DM, DFF, (bf16*)(wb + W_UP), P.in[I_NMLP] + l * DM, 0, scr, r, 128, lane); return; } r -= I_UP;
    transpose_item(P.in[I_WDOWN] + (size_t)l * DFF * DM, DFF, DM, (bf16*)(wb + W_DOWN), nullptr, 0, scr, r, 32, lane);
}
DI void convert_dynamic(const Params& P, ldsp L) {
    int t = threadIdx.x; asm volatile("" : "+v"(t)); const int lane = t & 63, wave = __builtin_amdgcn_readfirstlane(t >> 6);
    unsigned* ctr = (unsigned*)(P.ws + WS_CTL) + 64 * 2;
    LAS float* scr = (LAS float*)(L + 65536 + wave * 8704);
    for (;;) {
        unsigned u = 0u; if (lane == 0) u = atomicAdd(ctr, 4u);
        u = (unsigned)__builtin_amdgcn_readfirstlane((int)u);
        if (u >= (unsigned)I_LAYER) break;
        for (int k = 0; k < 4; ++k) if (u + k < (unsigned)I_LAYER) convert_item(P, scr, I_LAYER + (int)(u + k), lane);
    }
}
DI void prologue(const Params& P, ldsp L, int tid, int lane, int wave) {
    LAS float* scr = (LAS float*)(L + wave * 16384);
    const int gw = blockIdx.x * 8 + wave, NGW = gridDim.x * 8;
    for (int it = gw; it < I_LAYER; it += NGW) convert_item(P, scr, it, lane);
    float* hlead = (float*)(P.ws + WS_HLEAD); float* ssqA = (float*)(P.ws + WS_SSQA); bf16* hb = (bf16*)(P.ws + WS_HB);
    for (int row0 = gw; row0 < MMAIN + 16; row0 += 4 * NGW) {
        f32x4 v[4][4];
#pragma unroll
        for (int rr = 0; rr < 4; ++rr) { const int row = row0 + rr * NGW;
            if (row < MMAIN + 16) { const float* src = row < MMAIN ? P.in[I_X] + (size_t)row * DM : P.in[I_META] + (size_t)(row - MMAIN) * DM;
#pragma unroll
                for (int j = 0; j < 4; ++j) v[rr][j] = ((const f32x4*)src)[lane + 64 * j]; } }
#pragma unroll
        for (int rr = 0; rr < 4; ++rr) { const int row = row0 + rr * NGW;
            if (row < MMAIN + 16) {
                const int orow = row < MMAIN ? row : row + 16;
                float ss = 0.f;
#pragma unroll
                for (int j = 0; j < 4; ++j) ss += (v[rr][j][0] * v[rr][j][0] + v[rr][j][1] * v[rr][j][1]) + (v[rr][j][2] * v[rr][j][2] + v[rr][j][3] * v[rr][j][3]);
                ss = wave_sum(ss);
                if (row >= MMAIN) {
#pragma unroll
                    for (int j = 0; j < 4; ++j) ((f32x4*)(hlead + (size_t)(row - MMAIN) * DM))[lane + 64 * j] = v[rr][j]; }
#pragma unroll
                for (int j = 0; j < 4; ++j) { u32x2 w; w.x = pk2(v[rr][j][0], v[rr][j][1]); w.y = pk2(v[rr][j][2], v[rr][j][3]); ((u32x2*)(hb + (size_t)orow * DM))[lane + 64 * j] = w; }
                if (lane == 0) ssqA[orow] = ss; } }
    }
}

template <int MODE>
DI void lead_gemm(ldsp L, const bf16* A, const bf16* Wt, int N, int K, bf16* O, int ldo, const float* ssq_in, float* hlead, float* ssq_out) {
    int t = threadIdx.x; asm volatile("" : "+v"(t));
    const int lane = t & 63, wave = __builtin_amdgcn_readfirstlane(t >> 6), i = lane & 15, q = lane >> 4;
    int bx = blockIdx.x; asm volatile("" : "+s"(bx));
    const int ks = K >> 3;
    for (int tile = bx; tile < N / 16; tile += (int)gridDim.x) {
        const int n0 = tile * 16;
        const bf16* ap = A + (size_t)i * K + wave * ks + 8 * q; const bf16* bp = Wt + (size_t)(n0 + i) * K + wave * ks + 8 * q;
        f32x4 acc = {0.f, 0.f, 0.f, 0.f};
#pragma unroll 8
        for (int kk = 0; kk < ks; kk += 32) { const bf16x8 a = *(const bf16x8*)(ap + kk); const bf16x8 bb = *(const bf16x8*)(bp + kk); acc = __builtin_amdgcn_mfma_f32_16x16x32_bf16(a, bb, acc, 0, 0, 0); }
        *(LAS f32x4*)(L + (wave * 64 + lane) * 16) = acc;
        __syncthreads();
        if (wave == 0) {
#pragma unroll
            for (int w2 = 1; w2 < 8; ++w2) acc += *(const LAS f32x4*)(L + (w2 * 64 + lane) * 16);
#pragma unroll
            for (int j = 0; j < 4; ++j) { const int row = 4 * q + j;
                if (MODE == 2) { float* hp = hlead + (size_t)row * DM + n0 + i; const float v = *hp + acc[j]; *hp = v; O[(size_t)row * ldo + n0 + i] = f2bf1(v);
                    float sq = v * v; sq += __shfl_xor(sq, 1); sq += __shfl_xor(sq, 2); sq += __shfl_xor(sq, 4); sq += __shfl_xor(sq, 8);
                    if (i == 0) atomicAdd(ssq_out + row, sq); }
                else { const float rs = __builtin_amdgcn_rsqf(ssq_in[row] * (1.f / 1024.f) + EPS); float v = acc[j] * rs; if (MODE == 1) { v = fmaxf(v, 0.f); v = v * v; }
                    O[(size_t)row * ldo + n0 + i] = f2bf1(v); } }
        }
        __syncthreads();
    }
}

constexpr int VT_PITCH = 80;
DI void sb_unit(const Params& P, int layer, ldsp WL, int b, int hd, int qblk, int lane_) {
    int lane = lane_; asm volatile("" : "+v"(lane));
    const int r = lane & 31, h = lane >> 5;
    const bf16* proj = (const bf16*)(P.ws + WS_PROJ); bf16* mix = (bf16*)(P.ws + WS_MIX);
    const int t0 = qblk * 32, tq = t0 + r;
    const size_t rowq = rowof(b, tq);
    bf16* mixrow = mix + rowq * DM;
    const float* qn = P.in[I_QN] + layer * 64; const float* kn = P.in[I_KN] + layer * 64;
    u32x4 kraw[4], vraw[4], kn1[4], vn1[4];
    { const size_t rowk = rowof(b, 32 * qblk + r); const bf16* kp = proj + rowk * LDP + C_KSB + hd * 64; const bf16* vp = proj + rowk * LDP + C_VSB + hd * 64;
#pragma unroll
      for (int kk = 0; kk < 4; ++kk) { kraw[kk] = *(const u32x4*)(kp + 16 * kk + 8 * h); vraw[kk] = *(const u32x4*)(vp + 16 * kk + 8 * h); } }
    { const int kt1 = qblk > 3 ? qblk - 1 : 3; const size_t rowk = rowof(b, 32 * kt1 + r); const bf16* kp = proj + rowk * LDP + C_KSB + hd * 64; const bf16* vp = proj + rowk * LDP + C_VSB + hd * 64;
#pragma unroll
      for (int kk = 0; kk < 4; ++kk) { kn1[kk] = *(const u32x4*)(kp + 16 * kk + 8 * h); vn1[kk] = *(const u32x4*)(vp + 16 * kk + 8 * h); } }
    bf16x8 qf[4];
    {
        const bf16* qp = proj + rowq * LDP + C_QSB + hd * 64;
        u32x4 raw[4]; float ss = 0.f; f32x4 gq[4][2], gk[4][2];
#pragma unroll
        for (int kk = 0; kk < 4; ++kk) { raw[kk] = *(const u32x4*)(qp + 16 * kk + 8 * h);
            gq[kk][0] = *(const f32x4*)(qn + 16 * kk + 8 * h); gq[kk][1] = *(const f32x4*)(qn + 16 * kk + 8 * h + 4); gk[kk][0] = *(const f32x4*)(kn + 16 * kk + 8 * h); gk[kk][1] = *(const f32x4*)(kn + 16 * kk + 8 * h + 4); }
#pragma unroll
        for (int kk = 0; kk < 4; ++kk)
#pragma unroll
            for (int e = 0; e < 4; ++e) { const float a = bflo(raw[kk][e]), c = bfhi(raw[kk][e]); ss += a * a + c * c; }
        ss += __shfl_xor(ss, 32);
        const float rs = __builtin_amdgcn_rsqf(ss * (1.f / 64.f) + EPS) * (0.125f * 1.4426950408889634f);
#pragma unroll
        for (int kk = 0; kk < 4; ++kk) { u32x4 p;
#pragma unroll
            for (int e = 0; e < 4; ++e) { const float g0 = gq[kk][e >> 1][(2 * e) & 3] * gk[kk][e >> 1][(2 * e) & 3], g1 = gq[kk][e >> 1][(2 * e + 1) & 3] * gk[kk][e >> 1][(2 * e + 1) & 3]; p[e] = pk2(bflo(raw[kk][e]) * rs * g0, bfhi(raw[kk][e]) * rs * g1); }
            qf[kk] = __builtin_bit_cast(bf16x8, p); }
    }
    bf16x8 T0, T1;
#pragma unroll
    for (int j = 0; j < 8; ++j) { const int k0 = 8 * (j >> 2) + 4 * h + (j & 3); T0[j] = (k0 > r) ? (short)0x3F80 : (short)0; T1[j] = (16 + k0 > r) ? (short)0x3F80 : (short)0; }
    float R = 0.f; f32x16 o0 = zero16(), o1 = zero16();
    for (int kt = qblk; kt >= 3; --kt) {
#pragma unroll
        for (int kk = 0; kk < 4; ++kk)
#pragma unroll
            for (int e = 0; e < 4; ++e) { const int d = 16 * kk + 8 * h + 2 * e;
                *(LAS unsigned short*)(WL + d * VT_PITCH + r * 2) = (unsigned short)(vraw[kk][e] & 0xffffu);
                *(LAS unsigned short*)(WL + (d + 1) * VT_PITCH + r * 2) = (unsigned short)(vraw[kk][e] >> 16); }
        bf16x8 kf[4];
        { float ss = 0.f;
#pragma unroll
            for (int kk = 0; kk < 4; ++kk) { kf[kk] = __builtin_bit_cast(bf16x8, kraw[kk]);
#pragma unroll
                for (int e = 0; e < 4; ++e) { const float a = bflo(kraw[kk][e]), c = bfhi(kraw[kk][e]); ss += a * a + c * c; } }
            ss += __shfl_xor(ss, 32);
            *(LAS float*)(WL + 5120 + r * 4) = __builtin_amdgcn_rsqf(ss * (1.f / 64.f) + EPS); }
        {
            const int kt2 = kt - 2 >= 3 ? kt - 2 : 3;
            const size_t rowk = rowof(b, 32 * kt2 + r); const bf16* kp = proj + rowk * LDP + C_KSB + hd * 64; const bf16* vp = proj + rowk * LDP + C_VSB + hd * 64;
#pragma unroll
            for (int kk = 0; kk < 4; ++kk) { kraw[kk] = kn1[kk]; vraw[kk] = vn1[kk]; kn1[kk] = *(const u32x4*)(kp + 16 * kk + 8 * h); vn1[kk] = *(const u32x4*)(vp + 16 * kk + 8 * h); } }
        f32x16 zt = zero16();
#pragma unroll
        for (int kk = 0; kk < 4; ++kk) zt = MFMA32(kf[kk], qf[kk], zt);
        f32x16 lk, lh, ll; float tot = 0.f; unsigned vmask = 0u;
#pragma unroll
        for (int i = 0; i < 16; ++i) { const int ka = 32 * kt + crow(i, h); const bool valid = (ka < tq) && (ka >= NPAD); vmask |= valid ? (1u << i) : 0u;
            const float z = zt[i] * *(const LAS float*)(WL + 5120 + crow(i, h) * 4); const float e = __builtin_amdgcn_exp2f(-fabsf(z)); const float l = __builtin_amdgcn_logf(1.f + e);
            const float ls = fminf(z, 0.f) - l;
            const float lkv = valid ? (fminf(-z, 0.f) - l) : 0.f;
            lk[i] = lkv; tot += lkv; zt[i] = ls; }
#pragma unroll
        for (int i = 0; i < 16; i += 2) { const unsigned ph = pk2(lk[i], lk[i + 1]); lh[i] = bflo(ph); lh[i + 1] = bfhi(ph); ll[i] = lk[i] - lh[i]; ll[i + 1] = lk[i + 1] - lh[i + 1]; }
        f32x16 st = zero16();
        st = MFMA32(T0, pack8<0>(lh), st); st = MFMA32(T1, pack8<1>(lh), st); st = MFMA32(T0, pack8<0>(ll), st); st = MFMA32(T1, pack8<1>(ll), st);
        f32x16 wv;
#pragma unroll
        for (int i = 0; i < 16; ++i) { const float lw = zt[i] + st[i] + R; wv[i] = ((vmask >> i) & 1u) ? __builtin_amdgcn_exp2f(lw) : 0.f; }
        const bf16x8 wb0 = pack8<0>(wv), wb1 = pack8<1>(wv);
        {
            const bf16x8 a00 = lds_frag_perm(WL + r * VT_PITCH + (4 * h) * 2), a01 = lds_frag_perm(WL + r * VT_PITCH + (16 + 4 * h) * 2);
            const bf16x8 a10 = lds_frag_perm(WL + (r + 32) * VT_PITCH + (4 * h) * 2), a11 = lds_frag_perm(WL + (r + 32) * VT_PITCH + (16 + 4 * h) * 2);
            o0 = MFMA32(a00, wb0, o0); o0 = MFMA32(a01, wb1, o0); o1 = MFMA32(a10, wb0, o1); o1 = MFMA32(a11, wb1, o1);
        }
        tot += __shfl_xor(tot, 32); R += tot;
        if (__all(R < -153.f)) break;
    }
    float ss = 0.f;
#pragma unroll
    for (int i = 0; i < 16; ++i) ss += o0[i] * o0[i] + o1[i] * o1[i];
    ss += __shfl_xor(ss, 32);
    const float sc = __builtin_amdgcn_rsqf(ss * (1.f / 64.f) + EPS);
    const float* on = P.in[I_SBON] + layer * 256 + hd * 64;
#pragma unroll
    for (int g4 = 0; g4 < 4; ++g4) { const int d0 = 8 * g4 + 4 * h;
        const f32x4 w0 = *(const f32x4*)(on + d0), w1 = *(const f32x4*)(on + 32 + d0);
        u32x2 a, c; a.x = pk2(o0[4 * g4] * sc * w0[0], o0[4 * g4 + 1] * sc * w0[1]); a.y = pk2(o0[4 * g4 + 2] * sc * w0[2], o0[4 * g4 + 3] * sc * w0[3]);
        c.x = pk2(o1[4 * g4] * sc * w1[0], o1[4 * g4 + 1] * sc * w1[1]); c.y = pk2(o1[4 * g4 + 2] * sc * w1[2], o1[4 * g4 + 3] * sc * w1[3]);
        *(u32x2*)(mixrow + hd * 64 + d0) = a; *(u32x2*)(mixrow + hd * 64 + 32 + d0) = c; }
}

constexpr int B_ACUM = 0, B_DTV = 512, B_DTW = 1024, B_BIMG = 2048, B_CIMG = B_BIMG + 32 * 272, B_XT = B_CIMG + 32 * 272, BLOB_BYTES = B_XT + 256 * 80, BLOB_PIECES = BLOB_BYTES / 1024;
static_assert(BLOB_BYTES == 39 * 1024, "blob = 39 DMA pieces");
constexpr int S1_BT = 40960;
constexpr int NCH = 129;
DI unsigned char* ssd_blob(const Params& P, int b, int c, int g) { return P.ws + ((b < 4) ? WS_BLOB1 : WS_BLOB2) + (size_t)(((b & 3) * NCH + (c - 3)) * 2 + g) * BLOB_BYTES; }
#define VMWAIT0() asm volatile("s_waitcnt vmcnt(0)" ::: "memory")
#define LBAR() do { asm volatile("s_waitcnt lgkmcnt(0)" ::: "memory"); __builtin_amdgcn_s_barrier(); asm volatile("" ::: "memory"); } while (0)

constexpr int P_RAW = 51200;
DI void ssd_issue_raw(const bf16* proj, size_t rb, int g, ldsp L  , int w, int lane) {
    const int coloff = lane < 32 ? (C_X + g * 256 + lane * 8) : (lane < 48 ? (C_B + g * 128 + (lane - 32) * 8) : (C_C + g * 128 + (lane - 48) * 8));
#pragma unroll
    for (int q = 0; q < 4; ++q) { const int s = 4 * w + q;
        __builtin_amdgcn_global_load_lds((const unsigned*)(proj + (rb + s) * LDP + coloff), (LAS unsigned*)(L + s * 1024), 16, 0, 0); }
}
DI bf16x8 scale_frag(bf16x8 f, ldsp sc);
DI void ssd_sw1(const Params& P, int layer, ldsp L, int b, int g, int seg) {
    int tid_ = threadIdx.x; asm volatile("" : "+v"(tid_));
    const int tid = tid_, lane = tid & 63, w = __builtin_amdgcn_readfirstlane(tid >> 6);
    const int r = lane & 31, h = lane >> 5, hl = w >> 1, pt = w & 1;
    const bf16* proj = (const bf16*)(P.ws + WS_PROJ);
    const int c_begin = (seg == 0) ? 3 : 4 + 16 * seg, c_end = 20 + 16 * seg;
    unsigned short dtraw = 0, dtnext = 0;
    { const size_t rb0 = rowof(b, 32 * c_begin); ssd_issue_raw(proj, rb0, g, L + P_RAW, w, lane); if (tid < 128) dtraw = proj[(rb0 + (tid & 31)) * LDP + C_DT + 4 * g + ((tid >> 5) & 3)]; }
    int col, ch;
    if (tid < 256) { col = C_X + g * 256 + tid; ch = g * 256 + tid; } else if (tid < 384) { col = C_B + g * 128 + (tid - 256); ch = 512 + g * 128 + (tid - 256); } else { col = C_C + g * 128 + (tid - 384); ch = 768 + g * 128 + (tid - 384); }
    const float* cw = P.in[I_CONVW] + (size_t)layer * 4 * 1024;
    const float cw0 = cw[ch], cw1 = cw[1024 + ch], cw2 = cw[2048 + ch], cw3 = cw[3072 + ch], cb = P.in[I_CONVB][layer * 1024 + ch];
    float um3 = 0.f, um2 = 0.f, um1 = 0.f;
    if (seg > 0) { const size_t r3 = rowof(b, 32 * c_begin - 3); um3 = bf2f(proj[r3 * LDP + col]); um2 = bf2f(proj[(r3 + 1) * LDP + col]); um1 = bf2f(proj[(r3 + 2) * LDP + col]); }
    const int hl2 = (tid >> 5) & 3, s2 = tid & 31, head2 = 4 * g + hl2;
    const float dtb = P.in[I_DTB][layer * 8 + head2], aneg = -fexp(P.in[I_ALOG][layer * 8 + head2]);
    f32x16 st[4]; st[0] = zero16(); st[1] = zero16(); st[2] = zero16(); st[3] = zero16();
    float* Eb = (float*)(P.ws + WS_SSDE); float* Db = (float*)(P.ws + WS_SEGD);
    const int ub = ((b * 2 + g) * NSEG) * 8 + w;
    float logD = 0.f;
    VMWAIT0(); __syncthreads();
    const int xrow = (hl * 64 + 32 * pt + r) * 80;
    for (int c = c_begin; c < c_end; ++c) {
        const int t0 = 32 * c;
        const ldsp RW = L + P_RAW + (((c - c_begin) & 1) ? 32768 : 0);
        if (c + 1 < c_end) { const size_t rbn = rowof(b, t0 + 32); ssd_issue_raw(proj, rbn, g, L + P_RAW + (((c - c_begin) & 1) ? 0 : 32768), w, lane); if (tid < 128) dtnext = proj[(rbn + s2) * LDP + C_DT + head2]; }
        if (tid < 128) {
            const float dr = bf2f(dtraw) + dtb;
            const float dt = (t0 + s2 >= NPAD) ? (fmaxf(dr, 0.f) + log1pf(fexp(-fabsf(dr)))) : 0.f;
            float x = dt * aneg;
#pragma unroll
            for (int off = 1; off < 32; off <<= 1) { const float y = __builtin_bit_cast(float, __builtin_amdgcn_ds_bpermute(((s2 >= off) ? (lane - off) : lane) << 2, __builtin_bit_cast(int, x))); if (s2 >= off) x += y; }
            const float a31 = __builtin_bit_cast(float, __builtin_amdgcn_ds_bpermute((lane | 31) << 2, __builtin_bit_cast(int, x)));
            *(LAS float*)(L + B_ACUM + (hl2 * 32 + s2) * 4) = x; *(LAS float*)(L + B_DTV + (hl2 * 32 + s2) * 4) = dt; *(LAS float*)(L + B_DTW + (hl2 * 32 + s2) * 4) = dt * fexp(a31 - x);
        }
        {
            unsigned pb[16];
#pragma unroll
            for (int s = 0; s < 32; s += 2) { float a[2];
#pragma unroll
                for (int q = 0; q < 2; ++q) { const float u = (t0 + s + q >= NPAD) ? bf2f(*(const LAS unsigned short*)(RW + (s + q) * 1024 + tid * 2)) : 0.f;
                    const float cv = cb + cw0 * um3 + cw1 * um2 + cw2 * um1 + cw3 * u; um3 = um2; um2 = um1; um1 = u; a[q] = cv * __builtin_amdgcn_rcpf(1.f + fexp(-cv)); }
                const unsigned pp = pk2(a[0], a[1]); pb[s >> 1] = pp;
                if (tid >= 256) { const int img = (tid < 384) ? B_BIMG : B_CIMG; const int n = (tid < 384) ? (tid - 256) : (tid - 384);
                    *(LAS unsigned short*)(L + img + s * 272 + n * 2) = (unsigned short)(pp & 0xffffu); *(LAS unsigned short*)(L + img + (s + 1) * 272 + n * 2) = (unsigned short)(pp >> 16); } }
            if (tid < 384) { const int base = (tid < 256) ? (B_XT + tid * 80) : (S1_BT + (tid - 256) * 80);
#pragma unroll
                for (int q = 0; q < 4; ++q) *(LAS u32x4*)(L + base + q * 16) = (u32x4){pb[4 * q], pb[4 * q + 1], pb[4 * q + 2], pb[4 * q + 3]}; }
        }
        LBAR();
        VMWAIT0();
        {
            u32x4* gb = (u32x4*)ssd_blob(P, b, c, g);
            for (int i = tid; i < BLOB_BYTES / 16; i += 512) gb[i] = *(const LAS u32x4*)(L + i * 16);
        }
        {
            const float a31_ = *(const LAS float*)(L + B_ACUM + (hl * 32 + 31) * 4); logD += a31_;
            const float dec = fexp(a31_);
            const bf16x8 xw0 = scale_frag(lds_frag16(L + B_XT + xrow + (8 * h) * 2), L + B_DTW + (hl * 32 + 8 * h) * 4);
            const bf16x8 xw1 = scale_frag(lds_frag16(L + B_XT + xrow + (16 + 8 * h) * 2), L + B_DTW + (hl * 32 + 16 + 8 * h) * 4);
#pragma unroll
            for (int nt = 0; nt < 4; ++nt) {
#pragma unroll
                for (int i = 0; i < 16; ++i) st[nt][i] *= dec;
                st[nt] = MFMA32(lds_frag16(L + S1_BT + (32 * nt + r) * 80 + (8 * h) * 2), xw0, st[nt]);
                st[nt] = MFMA32(lds_frag16(L + S1_BT + (32 * nt + r) * 80 + (16 + 8 * h) * 2), xw1, st[nt]); }
        }
        LBAR();
        dtraw = dtnext;
    }
    {
        float* e = Eb + (size_t)(ub + 8 * seg) * 4096 + lane;
#pragma unroll
        for (int nt = 0; nt < 4; ++nt)
#pragma unroll
            for (int ii = 0; ii < 16; ++ii) e[(nt * 16 + ii) * 64] = st[nt][ii];
        if (lane == 0) Db[ub + 8 * seg] = fexp(logD);
    }
}

constexpr int W_SSQ = 3 * BLOB_BYTES, W_END = W_SSQ + 1024;
static_assert(W_END <= LDS_BAR, "ssd sweep lds");
DI void ssd_issue_blob(const unsigned char* gb, ldsp dst, int w, int lane) {
    for (int pc = w; pc < BLOB_PIECES; pc += 8) __builtin_amdgcn_global_load_lds((const unsigned*)(gb + pc * 1024 + lane * 16), (LAS unsigned*)(dst + pc * 1024), 16, 0, 0);
}
DI bf16x8 scale_frag(bf16x8 f, ldsp sc) {
    const u32x4 u = __builtin_bit_cast(u32x4, f); const f32x4 s0 = *(const LAS f32x4*)sc, s1 = *(const LAS f32x4*)(sc + 16);
    u32x4 o; o[0] = pk2(bflo(u[0]) * s0[0], bfhi(u[0]) * s0[1]); o[1] = pk2(bflo(u[1]) * s0[2], bfhi(u[1]) * s0[3]); o[2] = pk2(bflo(u[2]) * s1[0], bfhi(u[2]) * s1[1]); o[3] = pk2(bflo(u[3]) * s1[2], bfhi(u[3]) * s1[3]);
    return __builtin_bit_cast(bf16x8, o);
}
template <int MODE  >
DI void ssd_unit(const Params& P, int layer, ldsp L, int b, int g, int seg) {
    int tid_ = threadIdx.x; asm volatile("" : "+v"(tid_));
    const int tid = tid_, lane = tid & 63, w = __builtin_amdgcn_readfirstlane(tid >> 6);
    const int r = lane & 31, h = lane >> 5, hl = w >> 1, pt = w & 1, head = 4 * g + hl;
    const bf16* proj = (const bf16*)(P.ws + WS_PROJ); bf16* mix = (bf16*)(P.ws + WS_MIX);
    const float dsk = P.in[I_D][layer * 8 + head];
    const float* nw = P.in[I_SSDNW] + layer * 512 + g * 256 + hl * 64 + 32 * pt;
    f32x4 wnr[4];
#pragma unroll
    for (int g4 = 0; g4 < 4; ++g4) wnr[g4] = *(const f32x4*)(nw + 8 * g4 + 4 * h);
    f32x16 st[4]; st[0] = zero16(); st[1] = zero16(); st[2] = zero16(); st[3] = zero16();
    const int c_begin = (seg == 0) ? 3 : 4 + 16 * seg, c_end = 20 + 16 * seg;
    float* Eb = (float*)(P.ws + WS_SSDE); float* Db = (float*)(P.ws + WS_SEGD);
    const int ub = ((b * 2 + g) * NSEG) * 8 + w;
    ssd_issue_blob(ssd_blob(P, b, c_begin, g), L, w, lane);
    if (c_begin + 1 < c_end) ssd_issue_blob(ssd_blob(P, b, c_begin + 1, g), L + BLOB_BYTES, w, lane);
    if (MODE == 1) {
        for (int i = 0; i < seg; ++i) { const float d = Db[ub + 8 * i]; const float* e = Eb + (size_t)(ub + 8 * i) * 4096 + lane;
#pragma unroll
            for (int nt = 0; nt < 4; ++nt)
#pragma unroll
                for (int ii = 0; ii < 16; ++ii) st[nt][ii] = st[nt][ii] * d + e[(nt * 16 + ii) * 64]; }
    }
    VMWAIT0(); __syncthreads();
    float logD = 0.f;
    const int xrow = (hl * 64 + 32 * pt + r) * 80;
    u32x2 pend[4]; bf16* pend_row = nullptr;
    int slot = 0;
    for (int c = c_begin; c < c_end; ++c) {
        const ldsp I = L + slot * BLOB_BYTES;
        const size_t rowbase = rowof(b, 32 * c);
        u32x2 zr[4];
        if (MODE == 1) {
#pragma unroll
            for (int g4 = 0; g4 < 4; ++g4) zr[g4] = *(const u32x2*)(proj + (rowbase + r) * LDP + C_Z + head * 64 + 32 * pt + 8 * g4 + 4 * h); }
        if (MODE == 1 && pend_row) {
#pragma unroll
            for (int g4 = 0; g4 < 4; ++g4) *(u32x2*)(pend_row + 8 * g4 + 4 * h) = pend[g4]; }
        if (c + 2 < c_end) { const int s2_ = slot + 2 >= 3 ? slot - 1 : slot + 2; ssd_issue_blob(ssd_blob(P, b, c + 2, g), L + s2_ * BLOB_BYTES, w, lane); }
        f32x16 y = zero16(), yo = zero16(); float acum_t = 0.f;
        if (MODE == 1) {
            acum_t = *(const LAS float*)(I + B_ACUM + (hl * 32 + r) * 4);
            f32x16 gt = zero16();
#pragma unroll
            for (int ks = 0; ks < 8; ++ks) gt = MFMA32(lds_frag16(I + B_BIMG + r * 272 + (16 * ks + 8 * h) * 2), lds_frag16(I + B_CIMG + r * 272 + (16 * ks + 8 * h) * 2), gt);
#pragma unroll
            for (int i = 0; i < 16; ++i) { const int s = crow(i, h); const float as = *(const LAS float*)(I + B_ACUM + (hl * 32 + s) * 4), ds = *(const LAS float*)(I + B_DTV + (hl * 32 + s) * 4);
                gt[i] = (s <= r) ? gt[i] * fexp(acum_t - as) * ds : 0.f; }
            y = MFMA32(lds_frag_perm(I + B_XT + xrow + (4 * h) * 2), pack8<0>(gt), y);
            y = MFMA32(lds_frag_perm(I + B_XT + xrow + (16 + 4 * h) * 2), pack8<1>(gt), y);
#pragma unroll
            for (int nt = 0; nt < 4; ++nt) {
                yo = MFMA32(pack8<0>(st[nt]), lds_frag_perm(I + B_CIMG + r * 272 + (32 * nt + 4 * h) * 2), yo);
                yo = MFMA32(pack8<1>(st[nt]), lds_frag_perm(I + B_CIMG + r * 272 + (32 * nt + 16 + 4 * h) * 2), yo); }
        }
        const float eat = fexp(acum_t);
        const float a31_ = *(const LAS float*)(I + B_ACUM + (hl * 32 + 31) * 4); logD += a31_;
        const float dec = fexp(a31_);
        const bf16x8 xw0 = scale_frag(lds_frag16(I + B_XT + xrow + (8 * h) * 2), I + B_DTW + (hl * 32 + 8 * h) * 4);
        const bf16x8 xw1 = scale_frag(lds_frag16(I + B_XT + xrow + (16 + 8 * h) * 2), I + B_DTW + (hl * 32 + 16 + 8 * h) * 4);
#pragma unroll
        for (int nt = 0; nt < 4; ++nt) {
#pragma unroll
            for (int i = 0; i < 16; ++i) st[nt][i] *= dec;
            st[nt] = MFMA32(lds_frag_tr(I + B_BIMG, 272, 8 * h, 32 * nt, lane), xw0, st[nt]);
            st[nt] = MFMA32(lds_frag_tr(I + B_BIMG, 272, 16 + 8 * h, 32 * nt, lane), xw1, st[nt]); }
        if (MODE == 1) {
            float ss = 0.f;
#pragma unroll
            for (int i = 0; i < 16; ++i) { const int pl = 32 * pt + crow(i, h);
                const float xv = bf2f(*(const LAS unsigned short*)(I + B_XT + (hl * 64 + pl) * 80 + r * 2));
                const unsigned zw = zr[i >> 2][(i & 3) >> 1]; const float zv = (i & 1) ? bfhi(zw) : bflo(zw);
                float v = y[i] + eat * yo[i] + xv * dsk; v *= zv * __builtin_amdgcn_rcpf(1.f + fexp(-zv)); y[i] = v; ss += v * v; }
            ss += __shfl_xor(ss, 32);
            if (h == 0) *(LAS float*)(L + W_SSQ + (w * 32 + r) * 4) = ss;
            LBAR();
            float tot = 0.f;
#pragma unroll
            for (int q = 0; q < 8; ++q) tot += *(const LAS float*)(L + W_SSQ + (q * 32 + r) * 4);
            const float sc = __builtin_amdgcn_rsqf(tot * (1.f / 256.f) + EPS);
            pend_row = mix + (rowbase + r) * DM + 256 + head * 64 + 32 * pt;
#pragma unroll
            for (int g4 = 0; g4 < 4; ++g4) { const f32x4 wn = wnr[g4];
                u32x2 o; o.x = pk2(y[4 * g4] * sc * wn[0], y[4 * g4 + 1] * sc * wn[1]); o.y = pk2(y[4 * g4 + 2] * sc * wn[2], y[4 * g4 + 3] * sc * wn[3]);
                pend[g4] = o; }
        }
        if (c + 2 < c_end) { if (w < 7) asm volatile("s_waitcnt vmcnt(5)" ::: "memory"); else asm volatile("s_waitcnt vmcnt(4)" ::: "memory"); }
        else VMWAIT0();
        LBAR();
        slot = slot == 2 ? 0 : slot + 1;
    }
    if (MODE == 1 && pend_row) {
#pragma unroll
        for (int g4 = 0; g4 < 4; ++g4) *(u32x2*)(pend_row + 8 * g4 + 4 * h) = pend[g4]; }
    if (MODE == 0) {
        float* e = Eb + (size_t)(ub + 8 * seg) * 4096 + lane;
#pragma unroll
        for (int nt = 0; nt < 4; ++nt)
#pragma unroll
            for (int ii = 0; ii < 16; ++ii) e[(nt * 16 + ii) * 64] = st[nt][ii];
        if (lane == 0) Db[ub + 8 * seg] = fexp(logD);
    }
    __syncthreads();
}

constexpr int H_DK = 0, H_SSQ = 1024, H_HT = 2048, H_QIMG = 4096, H_KIMG = H_QIMG + 128 * 144, H_KHT = H_KIMG + 128 * 144, H_VT = H_KHT + 256 * 80, H_RAWF = H_VT + 256 * 80, H_RAWQ = H_RAWF + 16384, H_RAWI = H_RAWQ + 16384, H_RAWG = H_RAWI + 16384, H_END = H_RAWG + 16384;
static_assert(H_END <= LDS_BAR, "hgrn lds");
DI void hg_issue(const bf16* proj, size_t rb, ldsp L, int w, int lane, int planes  ) {
#pragma unroll
    for (int q = 0; q < 2; ++q) { const int s0 = 4 * w + 2 * q; const bf16* src = proj + (rb + s0 + (lane >> 5)) * LDP + (lane & 31) * 8;
        if (planes & 1) __builtin_amdgcn_global_load_lds((const unsigned*)(src + C_FHG), (LAS unsigned*)(L + H_RAWF + s0 * 512), 16, 0, 0);
        if (planes & 2) __builtin_amdgcn_global_load_lds((const unsigned*)(src + C_QHG), (LAS unsigned*)(L + H_RAWQ + s0 * 512), 16, 0, 0);
        if (planes & 4) __builtin_amdgcn_global_load_lds((const unsigned*)(src + C_IHG), (LAS unsigned*)(L + H_RAWI + s0 * 512), 16, 0, 0);
        if (planes & 8) __builtin_amdgcn_global_load_lds((const unsigned*)(src + C_GHG), (LAS unsigned*)(L + H_RAWG + s0 * 512), 16, 0, 0); }
}

template <int MODE>
DI void hgrn_unit(const Params& P, int layer, ldsp L, int b, int seg) {
    int tid_ = threadIdx.x; asm volatile("" : "+v"(tid_));
    const int tid = tid_, lane = tid & 63, w = __builtin_amdgcn_readfirstlane(tid >> 6);
    const int r = lane & 31, h = lane >> 5, hl = w >> 1, pt = w & 1;
    const bf16* proj = (const bf16*)(P.ws + WS_PROJ); bf16* mix = (bf16*)(P.ws + WS_MIX);
    const int j = tid & 255;
    hg_issue(proj, rowof(b, 32 * ((seg == 0) ? 3 : 4 + 8 * seg)), L, w, lane, MODE == 1 ? 15 : 5);
    float lb = 0.f;
    if (layer == 1) { const float l0 = P.in[I_LBL][j], l1 = P.in[I_LBL][256 + j]; lb = 1.f / (1.f + fexp(l1 - l0)); }
    const float oml = 1.f - lb;
    const float* onw = P.in[I_HGON] + layer * 256 + hl * 64 + 32 * pt;
    f32x16 st[2]; st[0] = zero16(); st[1] = zero16();
    f32x16 dacc[2];
#pragma unroll
    for (int i = 0; i < 16; ++i) { dacc[0][i] = 1.f; dacc[1][i] = 1.f; }
    const int c_begin = (seg == 0) ? 3 : 4 + 8 * seg, c_end = 12 + 8 * seg;
    float* Eb = (float*)(P.ws + WS_HGE); float* Db = (float*)(P.ws + WS_HGD);
    const int ub = (b * NSEG_HG) * 8 + w;
    if (MODE == 1) {
        for (int i = 0; i < seg; ++i) { const float* e = Eb + (size_t)(ub + 8 * i) * 2048 + lane; const float* d = Db + (size_t)(ub + 8 * i) * 2048 + lane;
#pragma unroll
            for (int nt = 0; nt < 2; ++nt)
#pragma unroll
                for (int ii = 0; ii < 16; ++ii) st[nt][ii] = st[nt][ii] * d[(nt * 16 + ii) * 64] + e[(nt * 16 + ii) * 64]; }
    }
    VMWAIT0(); __syncthreads();
    const int hf = tid >> 8, hlx = j >> 6, k = j & 63;
    u32x2 pend[4]; bf16* pend_row = nullptr;
    f32x4 onr[4];
#pragma unroll
    for (int g4 = 0; g4 < 4; ++g4) onr[g4] = *(const f32x4*)(onw + 8 * g4 + 4 * h);
    for (int c = c_begin; c < c_end; ++c) {
        const int t0 = 32 * c; const size_t rowbase = rowof(b, t0);
        u32x2 gr[4];
        if (MODE == 1) {
#pragma unroll
            for (int g4 = 0; g4 < 4; ++g4) gr[g4] = *(const LAS u32x2*)(L + H_RAWG + r * 512 + (hl * 64 + 32 * pt + 8 * g4 + 4 * h) * 2); }
        float bc[16], kk[16]; float run = 0.f;
#pragma unroll
        for (int s8 = 0; s8 < 16; ++s8) { const int s = 16 * hf + s8; const bool valid = (t0 + s >= NPAD); const float fl = bf2f(*(const LAS unsigned short*)(L + H_RAWF + s * 512 + j * 2));
            const float e = fexp(-fl); const float sg = __builtin_amdgcn_rcpf(1.f + e);
            const float f = lb + oml * sg; const float lf = valid ? flog(fmaxf(f, 1e-30f)) : 0.f;
            run += lf; bc[s8] = run; kk[s8] = valid ? oml * (1.f - sg) : 0.f; }
        *(LAS float*)(L + H_HT + (hf * 256 + j) * 4) = run;
        VMWAIT0(); LBAR();
        if (MODE == 1 && pend_row) {
#pragma unroll
            for (int g4 = 0; g4 < 4; ++g4) *(u32x2*)(pend_row + 8 * g4 + 4 * h) = pend[g4]; }
        if (c + 1 < c_end) hg_issue(proj, rowof(b, t0 + 32), L, w, lane, MODE == 1 ? 9 : 1);
        {
            const float tot0 = *(const LAS float*)(L + H_HT + j * 4), tot1 = *(const LAS float*)(L + H_HT + (256 + j) * 4);
            const float boff = hf ? tot0 : 0.f, b31 = tot0 + tot1;
            unsigned ph[8], pv[8];
#pragma unroll
            for (int s8 = 0; s8 < 16; s8 += 2) { float kh[2];
#pragma unroll
                for (int q = 0; q < 2; ++q) { const int s = 16 * hf + s8 + q; const float bcs = bc[s8 + q] + boff;
                    if (MODE == 1) {
                        const float qv = bf2f(*(const LAS unsigned short*)(L + H_RAWQ + s * 512 + j * 2)); const float qs = qv * __builtin_amdgcn_rcpf(1.f + fexp(-qv));
                        const float eb = fexp(bcs);
                        *(LAS unsigned short*)(L + H_QIMG + (hlx * 32 + s) * 144 + k * 2) = f2bf1(qs * eb);
                        *(LAS unsigned short*)(L + H_KIMG + (hlx * 32 + s) * 144 + k * 2) = f2bf1(kk[s8 + q] * fexp(fminf(-bcs, 80.f))); }
                    kh[q] = kk[s8 + q] * fexp(b31 - bcs); }
                ph[s8 >> 1] = pk2(kh[0], kh[1]);
                const int s = 16 * hf + s8;
                const unsigned lo = (t0 + s >= NPAD) ? (unsigned)*(const LAS unsigned short*)(L + H_RAWI + s * 512 + j * 2) : 0u;
                const unsigned hi = (t0 + s + 1 >= NPAD) ? (unsigned)*(const LAS unsigned short*)(L + H_RAWI + (s + 1) * 512 + j * 2) : 0u;
                pv[s8 >> 1] = lo | (hi << 16); }
#pragma unroll
            for (int q = 0; q < 2; ++q) { *(LAS u32x4*)(L + H_KHT + j * 80 + hf * 32 + q * 16) = (u32x4){ph[4 * q], ph[4 * q + 1], ph[4 * q + 2], ph[4 * q + 3]};
                *(LAS u32x4*)(L + H_VT + j * 80 + hf * 32 + q * 16) = (u32x4){pv[4 * q], pv[4 * q + 1], pv[4 * q + 2], pv[4 * q + 3]}; }
            if (hf == 0) *(LAS float*)(L + H_DK + j * 4) = fexp(b31);
        }
        LBAR();
        if (c + 1 < c_end) hg_issue(proj, rowof(b, t0 + 32), L, w, lane, MODE == 1 ? 6 : 4);
        const int vrow = (hl * 64 + 32 * pt + r) * 80;
        f32x16 y = zero16();
        if (MODE == 1) {
        f32x16 gt = zero16();
#pragma unroll
        for (int ks = 0; ks < 4; ++ks) gt = MFMA32(lds_frag16(L + H_KIMG + (hl * 32 + r) * 144 + (16 * ks + 8 * h) * 2), lds_frag16(L + H_QIMG + (hl * 32 + r) * 144 + (16 * ks + 8 * h) * 2), gt);
#pragma unroll
        for (int i = 0; i < 16; ++i) gt[i] = (crow(i, h) <= r) ? gt[i] : 0.f;
        y = MFMA32(lds_frag_perm(L + H_VT + vrow + (4 * h) * 2), pack8<0>(gt), y);
        y = MFMA32(lds_frag_perm(L + H_VT + vrow + (16 + 4 * h) * 2), pack8<1>(gt), y);
#pragma unroll
        for (int nt = 0; nt < 2; ++nt) {
            y = MFMA32(pack8<0>(st[nt]), lds_frag_perm(L + H_QIMG + (hl * 32 + r) * 144 + (32 * nt + 4 * h) * 2), y);
            y = MFMA32(pack8<1>(st[nt]), lds_frag_perm(L + H_QIMG + (hl * 32 + r) * 144 + (32 * nt + 16 + 4 * h) * 2), y); }
        }
#pragma unroll
        for (int nt = 0; nt < 2; ++nt) {
#pragma unroll
            for (int i = 0; i < 16; ++i) { const float dk_ = *(const LAS float*)(L + H_DK + (hl * 64 + 32 * nt + crow(i, h)) * 4); st[nt][i] *= dk_; if (MODE == 0) dacc[nt][i] *= dk_; }
            st[nt] = MFMA32(lds_frag16(L + H_KHT + (hl * 64 + 32 * nt + r) * 80 + (8 * h) * 2), lds_frag16(L + H_VT + vrow + (8 * h) * 2), st[nt]);
            st[nt] = MFMA32(lds_frag16(L + H_KHT + (hl * 64 + 32 * nt + r) * 80 + (16 + 8 * h) * 2), lds_frag16(L + H_VT + vrow + (16 + 8 * h) * 2), st[nt]); }
        if (MODE == 1) {
        float ss = 0.f;
#pragma unroll
        for (int i = 0; i < 16; ++i) ss += y[i] * y[i];
        ss += __shfl_xor(ss, 32);
        if (h == 0) *(LAS float*)(L + H_SSQ + (w * 32 + r) * 4) = ss;
        }
        if (c + 1 < c_end) { if (MODE == 1) asm volatile("s_waitcnt vmcnt(4)" ::: "memory"); else asm volatile("s_waitcnt vmcnt(2)" ::: "memory"); }
        else VMWAIT0();
        LBAR();
        if (MODE == 1) {
        const float tot = *(const LAS float*)(L + H_SSQ + ((2 * hl) * 32 + r) * 4) + *(const LAS float*)(L + H_SSQ + ((2 * hl + 1) * 32 + r) * 4);
        const float sc = __builtin_amdgcn_rsqf(tot * (1.f / 64.f) + EPS);
        bf16* mrow = mix + (rowbase + r) * DM + 768 + hl * 64 + 32 * pt;
#pragma unroll
        for (int g4 = 0; g4 < 4; ++g4) { const f32x4 wn = onr[g4];
            float o[4];
#pragma unroll
            for (int e = 0; e < 4; ++e) { const unsigned gw_ = gr[g4][e >> 1]; const float gv = (e & 1) ? bfhi(gw_) : bflo(gw_); o[e] = y[4 * g4 + e] * sc * wn[e] * (gv * __builtin_amdgcn_rcpf(1.f + fexp(-gv))); }
            u32x2 ov; ov.x = pk2(o[0], o[1]); ov.y = pk2(o[2], o[3]);
            pend[g4] = ov; }
        pend_row = mrow;
        }
    }
    if (MODE == 1 && pend_row) {
#pragma unroll
        for (int g4 = 0; g4 < 4; ++g4) *(u32x2*)(pend_row + 8 * g4 + 4 * h) = pend[g4]; }
    if (MODE == 0) {
        float* e = Eb + (size_t)(ub + 8 * seg) * 2048 + lane; float* d = Db + (size_t)(ub + 8 * seg) * 2048 + lane;
#pragma unroll
        for (int nt = 0; nt < 2; ++nt)
#pragma unroll
            for (int ii = 0; ii < 16; ++ii) { e[(nt * 16 + ii) * 64] = st[nt][ii]; d[(nt * 16 + ii) * 64] = dacc[nt][ii]; }
    }
}

constexpr unsigned SB_SPLIT = 4100u;
DI void sb_dynamic(const Params& P, int layer, ldsp L, int qi, unsigned u0, unsigned u1) {
    int t = threadIdx.x; asm volatile("" : "+v"(t)); const int lane = t & 63, wave = __builtin_amdgcn_readfirstlane(t >> 6);
    unsigned* ctr = (unsigned*)(P.ws + WS_CTL) + 64 * qi;
    for (;;) {
        unsigned u = 0u; if (lane == 0) u = atomicAdd(ctr, 1u);
        u = (unsigned)__builtin_amdgcn_readfirstlane((int)u) + u0;
        if (u >= u1) break;
        if (u < 3904u) { const int bh = (int)(u / 122u), qb = 131 - (int)(u % 122u); sb_unit(P, layer, L + wave * 8192, bh >> 2, bh & 3, qb, lane); }
        else if (u < 4096u) { const unsigned v = u - 3904u; const int bh = (int)(v / 6u), qb = 9 - (int)(v % 6u); sb_unit(P, layer, L + wave * 8192, bh >> 2, bh & 3, qb, lane); }
        else sb_unit(P, layer, L + wave * 8192, 0, (int)(u - 4096u), 3, lane);
    }
}
constexpr int CW_FLAG = 8192;
DI void wg_signal(unsigned* flag) {
    asm volatile("s_waitcnt vmcnt(0)" ::: "memory"); __syncthreads();
    if (threadIdx.x == 0) { __builtin_amdgcn_fence(__ATOMIC_RELEASE, "agent"); asm volatile("s_waitcnt vmcnt(0)" ::: "memory"); (void)__hip_atomic_fetch_add(flag, 1u, __ATOMIC_RELAXED, __HIP_MEMORY_SCOPE_AGENT); }
}
DI void wg_wait(unsigned* flag, unsigned want) {
    if (threadIdx.x == 0) { unsigned sp = 0;
        while (__hip_atomic_load(flag, __ATOMIC_RELAXED, __HIP_MEMORY_SCOPE_AGENT) < want) { __builtin_amdgcn_s_sleep(2); if (++sp > (1u << 22)) break; }
        __builtin_amdgcn_fence(__ATOMIC_ACQUIRE, "agent"); asm volatile("s_waitcnt vmcnt(0)" ::: "memory"); }
    __syncthreads();
}
DI int bxo_() { int b = blockIdx.x; asm volatile("" : "+s"(b)); return b; }
DI void zero_rows(float* p) { int t = threadIdx.x; asm volatile("" : "+v"(t)); int nt = gridDim.x * 512; asm volatile("" : "+s"(nt)); for (int i = bxo_() * 512 + t; i < MROWS; i += nt) p[i] = 0.f; }
DI int bxo() { int b = blockIdx.x; asm volatile("" : "+s"(b)); return b; }
__global__ void __launch_bounds__(512, 2) mega_fwd(Params P) {
    extern __shared__ __attribute__((aligned(16))) unsigned char lds_raw[];
    cg::grid_group grid = cg::this_grid();
    ldsp L = (ldsp)lds_raw;
    const int G = gridDim.x;
    unsigned char* ws = P.ws;
    float* hlead = (float*)(ws + WS_HLEAD); float* ssqA = (float*)(ws + WS_SSQA); float* ssqB = (float*)(ws + WS_SSQB);
    bf16* hb = (bf16*)(ws + WS_HB); bf16* proj = (bf16*)(ws + WS_PROJ); bf16* mix = (bf16*)(ws + WS_MIX); bf16* hid = (bf16*)(ws + WS_HID);

    if (threadIdx.x < 2) *(LAS unsigned*)(L + LDS_BAR + 4 * threadIdx.x) = 0u;
    __syncthreads();
    (void)xcd_barrier_post((unsigned*)(P.ws + WS_CTL) + CW_BAR, (volatile LAS unsigned*)(L + LDS_BAR));
    if (P.ws == nullptr) grid.sync();
    { int t = threadIdx.x; asm volatile("" : "+v"(t)); prologue(P, L, t, t & 63, __builtin_amdgcn_readfirstlane(t >> 6)); }
#define GSYNC() do { XcdBarrier b_; b_.bar = (unsigned*)(P.ws + WS_CTL) + CW_BAR; b_.x = xb_xcc_id(); b_.st = (volatile LAS unsigned*)(L + LDS_BAR); xcd_barrier(b_); } while (0)
    GSYNC();
    for (int l = 0; l < 2; ++l) {
        unsigned char* wb = ws + WS_W + (size_t)l * W_LAYER;
        zero_rows(ssqB);
        { int t = threadIdx.x; asm volatile("" : "+v"(t)); if (bxo() == 255) { u32x4* pz = (u32x4*)(proj + (size_t)MMAIN * LDP); const u32x4 z = {0u, 0u, 0u, 0u}; for (int i = t; i < 16 * LDP / 8; i += 512) pz[i] = z; } }
        lead_gemm<0>(L, hb + (size_t)LEADROW * DM, (const bf16*)(wb + W_IN), LDP, DM, proj + (size_t)LEADROW * LDP, LDP, ssqA + LEADROW, nullptr, nullptr);
        { pg8::Gemm g{hb, (const bf16*)(wb + W_IN), MMAIN, LDP, DM}; pg8::StaticOrder S; S.init(MMAIN, LDP, G, bxo());
          pg8::EpiScale<0> E{proj, LDP, ssqA};
          pg8::gemm_phase<pg8::EpiScale<0>, pg8::StaticOrder, true, true>(L, g, S, E); }
        GSYNC();
        zero_rows(ssqA);
        { const int bx = bxo();
          unsigned* flg = (unsigned*)(P.ws + WS_CTL) + CW_FLAG + 64 * (32 * l);
          if (bx < 128) { const int bg = bx >> 3, sg = bx & 7;
              ssd_sw1(P, l, L, bg >> 1, bg & 1, sg); wg_signal(flg + 64 * bg); wg_wait(flg + 64 * bg, 8u);
              ssd_unit<1>(P, l, L, bg >> 1, bg & 1, sg); }
          else { const int q = bx - 128, hb_ = q >> 4, sg = q & 15;
              if (sg < 15) { hgrn_unit<0>(P, l, L, hb_, sg); wg_signal(flg + 64 * (16 + hb_)); }
              wg_wait(flg + 64 * (16 + hb_), 15u);
              hgrn_unit<1>(P, l, L, hb_, sg); }
          __syncthreads();
          sb_dynamic(P, l, L, 4 + 2 * l, 0u, 4100u);
          if (l == 0) convert_dynamic(P, L); }
        GSYNC();
        lead_gemm<2>(L, mix + (size_t)LEADROW * DM, (const bf16*)(wb + W_OUT), DM, DM, hb + (size_t)LEADROW * DM, DM, nullptr, hlead, ssqB + LEADROW);
        { pg8::Gemm g{mix, (const bf16*)(wb + W_OUT), MMAIN, DM, DM}; pg8::StaticOrder S; S.init(MMAIN, DM, G, bxo());
          pg8::EpiResid E{(l == 0) ? P.in[I_X] : (const float*)P.out, P.out, hb, ssqB};
          pg8::gemm_phase<pg8::EpiResid, pg8::StaticOrder, true, true>(L, g, S, E); }
        GSYNC();
        lead_gemm<1>(L, hb + (size_t)LEADROW * DM, (const bf16*)(wb + W_UP), DFF, DM, hid + (size_t)LEADROW * DFF, DFF, ssqB + LEADROW, nullptr, nullptr);
        { pg8::Gemm g{hb, (const bf16*)(wb + W_UP), MMAIN, DFF, DM}; pg8::StaticOrder S; S.init(MMAIN, DFF, G, bxo());
          pg8::EpiScale<1> E{hid, DFF, ssqB};
          pg8::gemm_phase<pg8::EpiScale<1>, pg8::StaticOrder, true, true>(L, g, S, E); }
        GSYNC();
        lead_gemm<2>(L, hid + (size_t)LEADROW * DFF, (const bf16*)(wb + W_DOWN), DM, DFF, hb + (size_t)LEADROW * DM, DM, nullptr, hlead, ssqA + LEADROW);
        { pg8::Gemm g{hid, (const bf16*)(wb + W_DOWN), MMAIN, DM, DFF}; pg8::StaticOrder S; S.init(MMAIN, DM, G, bxo());
          pg8::EpiResid E{(const float*)P.out, P.out, hb, ssqA};
          pg8::gemm_phase<pg8::EpiResid, pg8::StaticOrder, true, true>(L, g, S, E); }
        if (l == 0) GSYNC();
    }
}

extern "C" void kernel_launch(void* const* d_in, const int* in_sizes, int n_in, void* d_out, int out_size, void* d_ws, size_t ws_size, hipStream_t stream) {
    static int grid = 0;
    if (grid == 0) {
        if (n_in != 19 || out_size != NB * SEQ * DM || ws_size < WS_END) { fprintf(stderr, "kernel_launch: unexpected shapes (n_in %d out %d ws %zu)\n", n_in, out_size, ws_size); grid = -1; return; }
        int dev = 0, cus = 0, per_cu = 0;
        hipGetDevice(&dev); hipDeviceGetAttribute(&cus, hipDeviceAttributeMultiprocessorCount, dev);
        hipFuncSetAttribute((const void*)mega_fwd, hipFuncAttributeMaxDynamicSharedMemorySize, LDS_BYTES);
        hipOccupancyMaxActiveBlocksPerMultiprocessor(&per_cu, (const void*)mega_fwd, 512, LDS_BYTES);
        (void)hipGetLastError();
        if (per_cu < 1) per_cu = 1;
        grid = cus;
        if (grid > 256) grid = 256;
    }
    if (grid < 0) return;
    Params p{};
    for (int i = 0; i < 19; ++i) p.in[i] = (const float*)d_in[i];
    p.out = (float*)d_out; p.ws = (unsigned char*)d_ws;
    (void)hipMemsetAsync(d_ws, 0, 65536, stream);
    void* args[] = {&p};
    hipError_t e = hipLaunchCooperativeKernel((const void*)mega_fwd, dim3(grid), dim3(512), args, LDS_BYTES, stream);
    if (e != hipSuccess) fprintf(stderr, "cooperative launch failed: %s (grid %d)\n", hipGetErrorString(e), grid);
}
```
